# Optimizing an MI355X kernel written in HIP

```python
import jax, jax.numpy as jnp
from jax import lax
import numpy as np

D_MODEL = 1024
BATCH = 2
SEQ = 8192
DEPTH = 2

CONV_CHANNELS = 512
CONV_GROUPS = 8
CONV_WIDTH = 3
N_Q_HEADS = 8
N_KV_HEADS = 2
HEAD_DIM = 64
ATTN_WIDTH = N_Q_HEADS * HEAD_DIM
WINDOW = 128
BLOCK = 128
MIX_WIDTH = CONV_CHANNELS + ATTN_WIDTH
IN_COLS = 3 * CONV_CHANNELS + (N_Q_HEADS + 2 * N_KV_HEADS) * HEAD_DIM
D_FF = -((-8 * D_MODEL) // (3 * 256)) * 256
EPS = 1e-6
NEG_INF = -1e30

kernel_name = "hymba_style_conv_swa_sink_hybrid"


def rms_norm(x, g):
    xf = x.astype(jnp.float32)
    y = xf * lax.rsqrt(jnp.mean(xf * xf, axis=-1, keepdims=True) + EPS)
    return (y * g.astype(jnp.float32)).astype(x.dtype)


def short_gated_conv(b_gate, c_gate, h, conv_w):
    seq = h.shape[1]
    u = c_gate * h
    up = jnp.pad(u, ((0, 0), (CONV_WIDTH - 1, 0), (0, 0)))
    y = conv_w[0] * up[:, 0:seq]
    for tap in range(1, CONV_WIDTH):
        y = y + conv_w[tap] * up[:, tap:tap + seq]
    return b_gate * y


def band_keys(t, nb):
    b = t.shape[0]
    tb = t.reshape(b, nb, BLOCK, t.shape[2], t.shape[3])
    prev = jnp.pad(tb[:, :-1], ((0, 0), (1, 0), (0, 0), (0, 0), (0, 0)))
    return jnp.concatenate([prev, tb], axis=2)


def sliding_window_attention_with_sinks(q, k, v, sinks):
    b, seq = q.shape[0], q.shape[1]
    nb = seq // BLOCK
    grp = N_Q_HEADS // N_KV_HEADS
    qb = q.reshape(b, nb, BLOCK, N_KV_HEADS, grp, HEAD_DIM)
    kb = band_keys(k, nb)
    vb = band_keys(v, nb)
    scale = HEAD_DIM ** -0.5
    s = jnp.einsum('bnqhgd,bnkhd->bnhgqk', qb, kb).astype(jnp.float32) * scale
    qpos = jnp.arange(nb)[:, None] * BLOCK + jnp.arange(BLOCK)[None, :]
    kpos = (jnp.arange(nb)[:, None] - 1) * BLOCK + jnp.arange(2 * BLOCK)[None, :]
    diff = qpos[:, :, None] - kpos[:, None, :]
    valid = (diff >= 0) & (diff < WINDOW) & (kpos[:, None, :] >= 0)
    s = jnp.where(valid[None, :, None, None], s, NEG_INF)
    sink = sinks.astype(jnp.float32).reshape(N_KV_HEADS, grp)[None, None, :, :, None, None]
    m = jnp.maximum(jnp.max(s, axis=-1, keepdims=True), sink)
    p = jnp.exp(s - m)
    denom = jnp.sum(p, axis=-1, keepdims=True) + jnp.exp(sink - m)
    probs = (p / denom).astype(v.dtype)
    o = jnp.einsum('bnhgqk,bnkhd->bnqhgd', probs, vb)
    return o.reshape(b, seq, ATTN_WIDTH)


def setup_inputs(seed: int = 0) -> dict:
    key = jax.random.key(seed)
    ks = jax.random.split(key, 16)
    f32 = jnp.float32

    def gain(k, shape):
        return 1.0 + 0.02 * jax.random.normal(k, shape, f32)

    return {
        "x": jax.random.normal(ks[0], (BATCH, SEQ, D_MODEL), f32),
        "norm1_g": gain(ks[1], (DEPTH, D_MODEL)),
        "w_in": jax.random.normal(ks[2], (DEPTH, D_MODEL, IN_COLS), f32) * D_MODEL ** -0.5,
        "conv_w": jax.random.normal(ks[3], (DEPTH, CONV_WIDTH, CONV_CHANNELS), f32) * CONV_WIDTH ** -0.5,
        "q_norm_g": gain(ks[4], (DEPTH, HEAD_DIM)),
        "k_norm_g": gain(ks[5], (DEPTH, HEAD_DIM)),
        "sinks": 0.5 * jax.random.normal(ks[6], (DEPTH, N_Q_HEADS), f32),
        "conv_out_g": gain(ks[7], (DEPTH, CONV_CHANNELS)),
        "attn_out_g": gain(ks[8], (DEPTH, ATTN_WIDTH)),
        "w_o": jax.random.normal(ks[9], (DEPTH, MIX_WIDTH, D_MODEL), f32) * MIX_WIDTH ** -0.5,
        "norm2_g": gain(ks[10], (DEPTH, D_MODEL)),
        "w_gate": jax.random.normal(ks[11], (DEPTH, D_MODEL, D_FF), f32) * D_MODEL ** -0.5,
        "w_up": jax.random.normal(ks[12], (DEPTH, D_MODEL, D_FF), f32) * D_MODEL ** -0.5,
        "w_down": jax.random.normal(ks[13], (DEPTH, D_FF, D_MODEL), f32) * D_FF ** -0.5,
    }


def reference(x, norm1_g, w_in, conv_w, q_norm_g, k_norm_g, sinks, conv_out_g,
              attn_out_g, w_o, norm2_g, w_gate, w_up, w_down):
    b, seq = x.shape[0], x.shape[1]
    c = CONV_CHANNELS
    o_q = 3 * c
    o_k = o_q + ATTN_WIDTH
    o_v = o_k + N_KV_HEADS * HEAD_DIM
    for l in range(DEPTH):
        h = rms_norm(x, norm1_g[l])
        proj = h @ w_in[l]
        b_gate = proj[..., 0:c]
        c_gate = proj[..., c:2 * c]
        hc = proj[..., 2 * c:3 * c]
        q = proj[..., o_q:o_k].reshape(b, seq, N_Q_HEADS, HEAD_DIM)
        k = proj[..., o_k:o_v].reshape(b, seq, N_KV_HEADS, HEAD_DIM)
        v = proj[..., o_v:].reshape(b, seq, N_KV_HEADS, HEAD_DIM)

        conv_out = short_gated_conv(b_gate, c_gate, hc, conv_w[l])

        q = rms_norm(q, q_norm_g[l])
        k = rms_norm(k, k_norm_g[l])
        attn_out = sliding_window_attention_with_sinks(q, k, v, sinks[l])

        mix = jnp.concatenate([rms_norm(conv_out, conv_out_g[l]),
                               rms_norm(attn_out, attn_out_g[l])], axis=-1)
        x = x + mix @ w_o[l]

        h2 = rms_norm(x, norm2_g[l])
        x = x + (jax.nn.silu(h2 @ w_gate[l]) * (h2 @ w_up[l])) @ w_down[l]
    return x
```

```cpp
#include <hip/hip_runtime.h>
#include <cstdio>
#include <cstdint>

typedef unsigned short bf16;
typedef short bf16x8 __attribute__((ext_vector_type(8)));
typedef float f32x16 __attribute__((ext_vector_type(16)));
typedef float f32x4 __attribute__((ext_vector_type(4)));

constexpr int D = 1024, M = 16384, SEQ = 8192, DEPTH = 2;
constexpr int CC = 512, NQ = 8, NKV = 2, HD = 64, AW = 512, WIN = 128;
constexpr int INC = 2304, DFF = 2816, NGU = 2 * DFF;
constexpr int O_Q = 1536, O_K = 2048, O_V = 2176;
constexpr float EPS = 1e-6f;

constexpr size_t MiB = 1u << 20;
constexpr size_t WS_CTL = 0;
constexpr size_t WS_W = 2 * MiB;
constexpr size_t W_IN = 0, W_O = (size_t)INC * D * 2, W_GU = W_O + (size_t)D * D * 2, W_D = W_GU + (size_t)NGU * D * 2, W_LAYER = W_D + (size_t)D * DFF * 2;
constexpr size_t WS_XB = 48 * MiB, WS_PROJ = 80 * MiB, WS_MIX = 152 * MiB, WS_ACT = 80 * MiB, WS_END = 184 * MiB;
static_assert(WS_W + 2 * W_LAYER <= WS_XB, "weights fit");

__device__ __forceinline__ unsigned f2bf(float f) { unsigned u = __builtin_bit_cast(unsigned, f); return (u + 0x7fffu + ((u >> 16) & 1u)) >> 16; }
__device__ __forceinline__ float bf2f(unsigned short h) { return __builtin_bit_cast(float, (unsigned)h << 16); }

__global__ void k_prep_w(const float* __restrict__ src, int K, int N, bf16* __restrict__ dst, int mode, const float* __restrict__ g0, const float* __restrict__ g1, int gsplit) {
    __shared__ float t[32][33];
    const int k0 = blockIdx.y * 32, n0 = blockIdx.x * 32, tx = threadIdx.x & 31, ty = threadIdx.x >> 5;
    for (int i = ty; i < 32; i += 8) {
        const int k = k0 + i; float gv = 1.f;
        if (g0) gv = (k < gsplit) ? g0[k] : g1[k - gsplit];
        t[i][tx] = src[(size_t)k * N + n0 + tx] * gv;
    }
    __syncthreads();
    for (int i = ty; i < 32; i += 8) {
        const int n = n0 + i; int r = n;
        if (mode) r = (n / 128) * 256 + (n % 128) + (mode == 2 ? 128 : 0);
        dst[(size_t)r * K + k0 + tx] = (bf16)f2bf(t[tx][i]);
    }
}

__global__ void k_xprep(const float* __restrict__ x, bf16* __restrict__ xb, float* __restrict__ rowss) {
    const int row = blockIdx.x * 4 + (threadIdx.x >> 6), lane = threadIdx.x & 63;
    const f32x4* xr = (const f32x4*)(x + (size_t)row * D);
    float s = 0.f;
#pragma unroll
    for (int j = 0; j < 4; ++j) {
        const f32x4 v = xr[lane + 64 * j];
        s += v.x * v.x + v.y * v.y + v.z * v.z + v.w * v.w;
        uint2 o; o.x = f2bf(v.x) | (f2bf(v.y) << 16); o.y = f2bf(v.z) | (f2bf(v.w) << 16);
        *(uint2*)(xb + (size_t)row * D + (lane + 64 * j) * 4) = o;
    }
#pragma unroll
    for (int o = 1; o < 64; o <<= 1) s += __shfl_xor(s, o);
    if (lane == 0) rowss[row] = s;
}

template <int EPI>
__global__ void __launch_bounds__(256) k_gemm(const bf16* __restrict__ A, const bf16* __restrict__ Bt, int K, const float* __restrict__ rowss, const float* res, float* outf, bf16* __restrict__ outb) {
    const int wave = threadIdx.x >> 6, lane = threadIdx.x & 63, r32 = lane & 31, hi = lane >> 5;
    const int row0 = blockIdx.y * 256 + wave * 64;
    int nb0, nb1, c0;
    if (EPI == 2) { c0 = blockIdx.x * 32; nb0 = (c0 / 128) * 256 + (c0 % 128); nb1 = nb0 + 128; }
    else { c0 = blockIdx.x * 64; nb0 = c0; nb1 = c0 + 32; }
    f32x16 acc[2][2];
#pragma unroll
    for (int i = 0; i < 2; ++i)
#pragma unroll
        for (int j = 0; j < 2; ++j)
#pragma unroll
            for (int r = 0; r < 16; ++r) acc[i][j][r] = 0.f;
    const bf16* a0 = A + (size_t)(row0 + r32) * K + hi * 8;
    const bf16* a1 = a0 + (size_t)32 * K;
    const bf16* b0 = Bt + (size_t)(nb0 + r32) * K + hi * 8;
    const bf16* b1 = Bt + (size_t)(nb1 + r32) * K + hi * 8;
    for (int k = 0; k < K; k += 16) {
        const bf16x8 fa0 = *(const bf16x8*)(a0 + k), fa1 = *(const bf16x8*)(a1 + k), fb0 = *(const bf16x8*)(b0 + k), fb1 = *(const bf16x8*)(b1 + k);
        acc[0][0] = __builtin_amdgcn_mfma_f32_32x32x16_bf16(fa0, fb0, acc[0][0], 0, 0, 0);
        acc[0][1] = __builtin_amdgcn_mfma_f32_32x32x16_bf16(fa0, fb1, acc[0][1], 0, 0, 0);
        acc[1][0] = __builtin_amdgcn_mfma_f32_32x32x16_bf16(fa1, fb0, acc[1][0], 0, 0, 0);
        acc[1][1] = __builtin_amdgcn_mfma_f32_32x32x16_bf16(fa1, fb1, acc[1][1], 0, 0, 0);
    }
#pragma unroll
    for (int i = 0; i < 2; ++i)
#pragma unroll
        for (int r = 0; r < 16; ++r) {
            const int row = row0 + i * 32 + (r & 3) + 8 * (r >> 2) + 4 * hi;
            if (EPI == 0) {
                const float rs = rsqrtf(rowss[row] * (1.f / D) + EPS);
                outb[(size_t)row * INC + nb0 + r32] = (bf16)f2bf(acc[i][0][r] * rs);
                outb[(size_t)row * INC + nb1 + r32] = (bf16)f2bf(acc[i][1][r] * rs);
            } else if (EPI == 1) {
                const size_t o0 = (size_t)row * D + nb0 + r32, o1 = (size_t)row * D + nb1 + r32;
                outf[o0] = res[o0] + acc[i][0][r];
                outf[o1] = res[o1] + acc[i][1][r];
            } else {
                const float rs = rsqrtf(rowss[row] * (1.f / D) + EPS);
                const float g = acc[i][0][r] * rs, u = acc[i][1][r] * rs;
                const float a = g / (1.f + __expf(-g)) * u;
                outb[(size_t)row * DFF + c0 + r32] = (bf16)f2bf(a);
            }
        }
}

__global__ void k_conv(const bf16* __restrict__ proj, const float* __restrict__ conv_w, bf16* __restrict__ mix) {
    const int tok = blockIdx.x * 4 + (threadIdx.x >> 6), lane = threadIdx.x & 63, t = tok % SEQ, c0 = lane * 8;
    float y[8];
#pragma unroll
    for (int j = 0; j < 8; ++j) y[j] = 0.f;
#pragma unroll
    for (int tap = 0; tap < 3; ++tap) {
        const int dt = 2 - tap;
        if (t - dt >= 0) {
            const bf16* pr = proj + (size_t)(tok - dt) * INC;
            const bf16x8 cg = *(const bf16x8*)(pr + CC + c0), hc = *(const bf16x8*)(pr + 2 * CC + c0);
#pragma unroll
            for (int j = 0; j < 8; ++j) y[j] += conv_w[tap * CC + c0 + j] * (bf2f((unsigned short)cg[j]) * bf2f((unsigned short)hc[j]));
        }
    }
    const bf16x8 bg = *(const bf16x8*)(proj + (size_t)tok * INC + c0);
    float s = 0.f;
#pragma unroll
    for (int j = 0; j < 8; ++j) { y[j] *= bf2f((unsigned short)bg[j]); s += y[j] * y[j]; }
#pragma unroll
    for (int o = 1; o < 64; o <<= 1) s += __shfl_xor(s, o);
    const float rs = rsqrtf(s * (1.f / CC) + EPS);
    uint4 o;
    o.x = f2bf(y[0] * rs) | (f2bf(y[1] * rs) << 16); o.y = f2bf(y[2] * rs) | (f2bf(y[3] * rs) << 16);
    o.z = f2bf(y[4] * rs) | (f2bf(y[5] * rs) << 16); o.w = f2bf(y[6] * rs) | (f2bf(y[7] * rs) << 16);
    *(uint4*)(mix + (size_t)tok * D + c0) = o;
}

__global__ void __launch_bounds__(512) k_attn(const bf16* __restrict__ proj, const float* __restrict__ qg, const float* __restrict__ kg, const float* __restrict__ sinks, bf16* __restrict__ mix) {
    __shared__ float sq[8][64];
    __shared__ float sp[8][128];
    __shared__ float sred[8];
    const int tok = blockIdx.x, h = threadIdx.x >> 6, lane = threadIdx.x & 63, t = tok % SEQ, kvh = h / 4;
    const float qv = bf2f(proj[(size_t)tok * INC + O_Q + h * HD + lane]);
    float s = qv * qv;
#pragma unroll
    for (int o = 1; o < 64; o <<= 1) s += __shfl_xor(s, o);
    sq[h][lane] = qv * rsqrtf(s * (1.f / HD) + EPS) * qg[lane] * 0.125f;
    __syncthreads();
    float sc[2];
#pragma unroll
    for (int half = 0; half < 2; ++half) {
        const int j = lane + 64 * half, kp = t - (WIN - 1) + j;
        float v = -1e30f;
        if (kp >= 0) {
            const bf16* kr = proj + (size_t)(tok - (WIN - 1) + j) * INC + O_K + kvh * HD;
            float dot = 0.f, ss = 0.f;
#pragma unroll
            for (int d8 = 0; d8 < 8; ++d8) {
                const bf16x8 kk = *(const bf16x8*)(kr + d8 * 8);
#pragma unroll
                for (int e = 0; e < 8; ++e) { const float kf = bf2f((unsigned short)kk[e]); ss += kf * kf; dot += kf * kg[d8 * 8 + e] * sq[h][d8 * 8 + e]; }
            }
            v = dot * rsqrtf(ss * (1.f / HD) + EPS);
        }
        sc[half] = v;
    }
    const float sink = sinks[h];
    float m = fmaxf(fmaxf(sc[0], sc[1]), sink);
#pragma unroll
    for (int o = 1; o < 64; o <<= 1) m = fmaxf(m, __shfl_xor(m, o));
    const float p0 = (sc[0] > -1e29f) ? __expf(sc[0] - m) : 0.f, p1 = (sc[1] > -1e29f) ? __expf(sc[1] - m) : 0.f;
    float den = p0 + p1;
#pragma unroll
    for (int o = 1; o < 64; o <<= 1) den += __shfl_xor(den, o);
    den += __expf(sink - m);
    sp[h][lane] = p0 / den; sp[h][lane + 64] = p1 / den;
    __syncthreads();
    float o = 0.f;
    for (int j = 0; j < WIN; ++j) {
        const int kp = t - (WIN - 1) + j;
        if (kp >= 0) o += sp[h][j] * bf2f(proj[(size_t)(tok - (WIN - 1) + j) * INC + O_V + kvh * HD + lane]);
    }
    float ss = o * o;
#pragma unroll
    for (int of = 1; of < 64; of <<= 1) ss += __shfl_xor(ss, of);
    if (lane == 0) sred[h] = ss;
    __syncthreads();
    float tot = 0.f;
#pragma unroll
    for (int i = 0; i < 8; ++i) tot += sred[i];
    mix[(size_t)tok * D + CC + h * HD + lane] = (bf16)f2bf(o * rsqrtf(tot * (1.f / AW) + EPS));
}

extern "C" void kernel_launch(void* const* d_in, const int* in_sizes, int n_in, void* d_out, int out_size, void* d_ws, size_t ws_size, hipStream_t stream) {
    if (n_in != 14 || out_size != M * D || ws_size < WS_END) { fprintf(stderr, "kernel_launch: unexpected shapes (n_in %d out %d ws %zu)\n", n_in, out_size, ws_size); return; }
    const float* x = (const float*)d_in[0]; const float* norm1_g = (const float*)d_in[1]; const float* w_in = (const float*)d_in[2]; const float* conv_w = (const float*)d_in[3];
    const float* q_norm_g = (const float*)d_in[4]; const float* k_norm_g = (const float*)d_in[5]; const float* sinks = (const float*)d_in[6]; const float* conv_out_g = (const float*)d_in[7];
    const float* attn_out_g = (const float*)d_in[8]; const float* w_o = (const float*)d_in[9]; const float* norm2_g = (const float*)d_in[10]; const float* w_gate = (const float*)d_in[11];
    const float* w_up = (const float*)d_in[12]; const float* w_down = (const float*)d_in[13];
    unsigned char* ws = (unsigned char*)d_ws; float* out = (float*)d_out;
    float* rowss = (float*)(ws + WS_CTL);
    bf16* XB = (bf16*)(ws + WS_XB); bf16* PROJ = (bf16*)(ws + WS_PROJ); bf16* MIX = (bf16*)(ws + WS_MIX); bf16* ACT = (bf16*)(ws + WS_ACT);
    for (int l = 0; l < DEPTH; ++l) {
        unsigned char* wl = ws + WS_W + l * W_LAYER;
        k_prep_w<<<dim3(INC / 32, D / 32), 256, 0, stream>>>(w_in + (size_t)l * D * INC, D, INC, (bf16*)(wl + W_IN), 0, norm1_g + l * D, norm1_g + l * D, D);
        k_prep_w<<<dim3(D / 32, D / 32), 256, 0, stream>>>(w_o + (size_t)l * D * D, D, D, (bf16*)(wl + W_O), 0, conv_out_g + l * CC, attn_out_g + l * AW, CC);
        k_prep_w<<<dim3(DFF / 32, D / 32), 256, 0, stream>>>(w_gate + (size_t)l * D * DFF, D, DFF, (bf16*)(wl + W_GU), 1, norm2_g + l * D, norm2_g + l * D, D);
        k_prep_w<<<dim3(DFF / 32, D / 32), 256, 0, stream>>>(w_up + (size_t)l * D * DFF, D, DFF, (bf16*)(wl + W_GU), 2, norm2_g + l * D, norm2_g + l * D, D);
        k_prep_w<<<dim3(D / 32, DFF / 32), 256, 0, stream>>>(w_down + (size_t)l * DFF * D, DFF, D, (bf16*)(wl + W_D), 0, nullptr, nullptr, 0);
    }
    for (int l = 0; l < DEPTH; ++l) {
        unsigned char* wl = ws + WS_W + l * W_LAYER;
        const float* xin = (l == 0) ? x : out;
        k_xprep<<<M / 4, 256, 0, stream>>>(xin, XB, rowss);
        k_gemm<0><<<dim3(INC / 64, M / 256), 256, 0, stream>>>(XB, (const bf16*)(wl + W_IN), D, rowss, nullptr, nullptr, PROJ);
        k_conv<<<M / 4, 256, 0, stream>>>(PROJ, conv_w + l * 3 * CC, MIX);
        k_attn<<<M, 512, 0, stream>>>(PROJ, q_norm_g + l * HD, k_norm_g + l * HD, sinks + l * NQ, MIX);
        k_gemm<1><<<dim3(D / 64, M / 256), 256, 0, stream>>>(MIX, (const bf16*)(wl + W_O), D, nullptr, xin, out, nullptr);
        k_xprep<<<M / 4, 256, 0, stream>>>(out, XB, rowss);
        k_gemm<2><<<dim3(DFF / 32, M / 256), 256, 0, stream>>>(XB, (const bf16*)(wl + W_GU), D, rowss, nullptr, nullptr, ACT);
        k_gemm<1><<<dim3(D / 64, M / 256), 256, 0, stream>>>(ACT, (const bf16*)(wl + W_D), DFF, nullptr, out, out, nullptr);
    }
}
```

```cpp
#include <hip/hip_runtime.h>
#include <cstdio>
#include <cstdint>

namespace pg8 {
#define PG8_LAS __attribute__((address_space(3)))
typedef unsigned short bf16_t;
typedef short bf16x8 __attribute__((ext_vector_type(8)));
typedef float f32x4 __attribute__((ext_vector_type(4)));
typedef unsigned u32x4 __attribute__((ext_vector_type(4)));
constexpr int BM = 256, BK = 64, HALF = 128, HTB = HALF * BK * 2  , STAGE_BYTES = 8 * HTB, NXCD = 8, WGM = 8;

__host__ __device__ __forceinline__ int lds_byte(int r, int c) { const int st = (r >> 4) * 2 + (c >> 5), rr = r & 15, cc = c & 31, ob = rr * 64 + cc * 2; return st * 1024 + (ob ^ (((ob >> 9) & 1) << 5)); }
__host__ __device__ __forceinline__ void stage_rc(int b, int& R, int& C) { const int st = b / 1024, sb = b % 1024, swz = sb ^ (((sb >> 9) & 1) << 5); R = (st >> 1) * 16 + swz / 64; C = (st & 1) * 32 + (swz % 64) / 2; }
__host__ __device__ __forceinline__ int perm32(int rho) { const int n = rho >> 4, i = rho & 15; return 8 * (i >> 2) + 4 * n + (i & 3); }

struct Unit { int pm, pn; };
struct Gemm { const bf16_t* A; const bf16_t* Bt; int M, N, K; };

struct StaticOrder {
    int nM, nN, nwg, G, c;
    __host__ __device__ void init(int M, int N, int G_, int c_) { nM = M / BM; nN = N / BM; nwg = nM * nN; G = G_; c = c_; }
    __host__ __device__ bool next(int i, Unit& u) const {
        const long L = (long)i * G + c; if (L >= nwg) return false;
        int wgid = (int)L; { const int q = nwg / NXCD, r = nwg % NXCD, xcd = wgid % NXCD, off = wgid / NXCD; wgid = (xcd < r ? xcd * (q + 1) : r * (q + 1) + (xcd - r) * q) + off; }
        const int nig = WGM * nN, gid = wgid / nig, fm = gid * WGM, gsz = (nM - fm) < WGM ? (nM - fm) : WGM;
        u.pm = fm + ((wgid % nig) % gsz); u.pn = (wgid % nig) / gsz; return true;
    }
    __device__ __forceinline__ void a_ready(const Unit&) const {}
    __device__ __forceinline__ void done(const Unit&) const {}
};

__device__ __forceinline__ unsigned cvt_pk_bf16(float lo, float hi) { unsigned r; asm volatile("v_cvt_pk_bf16_f32 %0, %1, %2" : "=v"(r) : "v"(lo), "v"(hi)); return r; }
constexpr float RMS_EPS = 1e-6f;
__device__ __forceinline__ float row_rs(const float* rowss, int row) { return __builtin_amdgcn_rsqf(rowss[row] * (1.0f / 1024.0f) + RMS_EPS); }
struct EpiProj {
    static constexpr bool PERM = true, AFTER_DRAIN = false;
    bf16_t* O; int ldc; const float* rowss;
    __device__ __forceinline__ void operator()(const f32x4 (&acc)[2][2][4][2], const Unit& u, int wr, int wc, int fr, int fq) const {
        const int row0 = u.pm * BM + wr * 64 + fr, col0 = u.pn * BM + wc * 32 + 8 * fq;
#pragma unroll
        for (int ai = 0; ai < 2; ++ai)
#pragma unroll
            for (int m = 0; m < 4; ++m) { const int row = row0 + ai * HALF + m * 16; const float rs = row_rs(rowss, row); bf16_t* rowp = O + (size_t)row * ldc + col0;
#pragma unroll
                for (int bj = 0; bj < 2; ++bj) { const f32x4 v0 = acc[ai][bj][m][0] * rs, v1 = acc[ai][bj][m][1] * rs;
                    u32x4 w; w.x = cvt_pk_bf16(v0[0], v0[1]); w.y = cvt_pk_bf16(v0[2], v0[3]); w.z = cvt_pk_bf16(v1[0], v1[1]); w.w = cvt_pk_bf16(v1[2], v1[3]);
                    *(u32x4*)(rowp + bj * HALF) = w; } }
    }
};
__device__ __forceinline__ float swiglu1(float g, float u) { return g * u * __builtin_amdgcn_rcpf(1.0f + __builtin_amdgcn_exp2f(g * -1.4426950408889634f)); }
struct EpiGU {
    static constexpr bool PERM = true, AFTER_DRAIN = false;
    bf16_t* O; int ldc; const float* rowss;
    __device__ __forceinline__ void operator()(const f32x4 (&acc)[2][2][4][2], const Unit& u, int wr, int wc, int fr, int fq) const {
        const int row0 = u.pm * BM + wr * 64 + fr, col0 = u.pn * HALF + wc * 32 + 8 * fq;
#pragma unroll
        for (int ai = 0; ai < 2; ++ai)
#pragma unroll
            for (int m = 0; m < 4; ++m) { const int row = row0 + ai * HALF + m * 16; const float rs = row_rs(rowss, row);
                const f32x4 g0 = acc[ai][0][m][0] * rs, g1 = acc[ai][0][m][1] * rs, u0 = acc[ai][1][m][0] * rs, u1 = acc[ai][1][m][1] * rs;
                u32x4 w; w.x = cvt_pk_bf16(swiglu1(g0[0], u0[0]), swiglu1(g0[1], u0[1])); w.y = cvt_pk_bf16(swiglu1(g0[2], u0[2]), swiglu1(g0[3], u0[3]));
                w.z = cvt_pk_bf16(swiglu1(g1[0], u1[0]), swiglu1(g1[1], u1[1])); w.w = cvt_pk_bf16(swiglu1(g1[2], u1[2]), swiglu1(g1[3], u1[3]));
                *(u32x4*)(O + (size_t)row * ldc + col0) = w; }
    }
};
struct EpiRes {
    static constexpr bool PERM = true, AFTER_DRAIN = false;
    const float* res; float* out; bf16_t* xb; float* rowss_next;
    __device__ __forceinline__ void operator()(const f32x4 (&acc)[2][2][4][2], const Unit& u, int wr, int wc, int fr, int fq) const {
        const int row0 = u.pm * BM + wr * 64 + fr, col0 = u.pn * BM + wc * 32 + 8 * fq;
#pragma unroll
        for (int ai = 0; ai < 2; ++ai)
#pragma unroll
            for (int m = 0; m < 4; ++m) { const int row = row0 + ai * HALF + m * 16; const size_t off = (size_t)row * 1024 + col0; float ss = 0.f;
#pragma unroll
                for (int bj = 0; bj < 2; ++bj) { const f32x4 r0 = *(const f32x4*)(res + off + bj * HALF), r1 = *(const f32x4*)(res + off + bj * HALF + 4);
                    const f32x4 v0 = r0 + acc[ai][bj][m][0], v1 = r1 + acc[ai][bj][m][1];
                    *(f32x4*)(out + off + bj * HALF) = v0; *(f32x4*)(out + off + bj * HALF + 4) = v1;
                    if (xb) { u32x4 w; w.x = cvt_pk_bf16(v0[0], v0[1]); w.y = cvt_pk_bf16(v0[2], v0[3]); w.z = cvt_pk_bf16(v1[0], v1[1]); w.w = cvt_pk_bf16(v1[2], v1[3]);
                        *(u32x4*)(xb + off + bj * HALF) = w;
                        ss += (v0[0] * v0[0] + v0[1] * v0[1]) + (v0[2] * v0[2] + v0[3] * v0[3]) + (v1[0] * v1[0] + v1[1] * v1[1]) + (v1[2] * v1[2] + v1[3] * v1[3]); } }
                if (xb) { ss += __shfl_xor(ss, 16); ss += __shfl_xor(ss, 32); if (fq == 0) atomicAdd(rowss_next + row, ss); } }
    }
};

template <class Epi, class Sched, bool ALIGN_EPI = false, bool SP2 = false>
__device__ __forceinline__ void gemm_phase(PG8_LAS unsigned char* lds, const Gemm g, const Sched& S, const Epi& E, const int tid) {
    const int  wid = __builtin_amdgcn_readfirstlane(tid >> 6), lane = tid & 63, wr = wid >> 2, wc = wid & 3, fr = lane & 15, fq = lane >> 4;
    const int K = g.K, nt = K / BK;
    unsigned voffA[2], voffB[2];
#pragma unroll
    for (int i = 0; i < 2; ++i) { int R, C; stage_rc(tid * 16 + i * 8192, R, C); const int Rb = Epi::PERM ? ((R & ~31) + perm32(R & 31)) : R;
        voffA[i] = (unsigned)(R * K + C) * 2u; voffB[i] = (unsigned)(Rb * K + C) * 2u; }
    const size_t kstep = (size_t)(BK * 2);
    const size_t hstep = (size_t)HALF * K * 2;
    const size_t tstep = 2 * hstep;
    const unsigned ldsw = (unsigned)wid * 1024u;
    const int aoff = lds_byte(wr * 64 + fr, fq * 8), boff = lds_byte(wc * 32 + fr, fq * 8);
#define PG8_SA(b, h) (((b) * 2 + (h)) * HTB)
#define PG8_SB(b, h) ((4 + (b) * 2 + (h)) * HTB)
#define PG8_STAGE(bufoff, gbase, voff) do { _Pragma("unroll") for (int _i = 0; _i < 2; ++_i) \
        __builtin_amdgcn_global_load_lds((const unsigned*)((const char*)(gbase) + (voff)[_i]), (PG8_LAS unsigned*)(lds + (bufoff) + ldsw + _i * 8192), 16, 0, 0); } while (0)
#define PG8_LDA(dst, b, h) do { _Pragma("unroll") for (int m = 0; m < 4; ++m) _Pragma("unroll") for (int k = 0; k < 2; ++k) dst[m][k] = *(const PG8_LAS bf16x8*)(lds + PG8_SA(b, h) + aoff + m * 2048 + k * 1024); } while (0)
#define PG8_LDB(dst, b, h) do { _Pragma("unroll") for (int n = 0; n < 2; ++n) _Pragma("unroll") for (int k = 0; k < 2; ++k) dst[n][k] = *(const PG8_LAS bf16x8*)(lds + PG8_SB(b, h) + boff + n * 2048 + k * 1024); } while (0)
#define PG8_MMA(ai, bj, At, Bt) do { __builtin_amdgcn_s_setprio(1); _Pragma("unroll") for (int m = 0; m < 4; ++m) _Pragma("unroll") for (int n = 0; n < 2; ++n) _Pragma("unroll") for (int k = 0; k < 2; ++k) \
        acc[ai][bj][m][n] = __builtin_amdgcn_mfma_f32_16x16x32_bf16(Bt[n][k], At[m][k], acc[ai][bj][m][n], 0, 0, 0); __builtin_amdgcn_s_setprio(0); } while (0)
#define PG8_WAIT_V(n) asm volatile("s_waitcnt vmcnt(" #n ")" ::: "memory")
#define PG8_WAIT_L(n) asm volatile("s_waitcnt lgkmcnt(" #n ")" ::: "memory")
#define PG8_BAR __builtin_amdgcn_s_barrier()
#define PG8_SCHED __builtin_amdgcn_sched_barrier(0)
    Unit cur, nxt; int ui = 0;
    if (!S.next(0, cur)) return;
    f32x4 acc[2][2][4][2];
#pragma unroll
    for (int a = 0; a < 2; ++a)
#pragma unroll
        for (int b = 0; b < 2; ++b)
#pragma unroll
            for (int m = 0; m < 4; ++m)
#pragma unroll
                for (int n = 0; n < 2; ++n) acc[a][b][m][n] = (f32x4){0.f, 0.f, 0.f, 0.f};
    bf16x8 At[4][2], B0[2][2], B1[2][2];
    const char* cA = (const char*)g.A + (size_t)cur.pm * tstep; const char* cB = (const char*)g.Bt + (size_t)cur.pn * tstep;
    S.a_ready(cur);
    if constexpr (SP2) {
        PG8_STAGE(PG8_SB(0, 0), cB, voffB); PG8_STAGE(PG8_SB(0, 1), cB + hstep, voffB); PG8_STAGE(PG8_SA(0, 0), cA, voffA); PG8_STAGE(PG8_SA(0, 1), cA + hstep, voffA);
        if (wr == 1) PG8_BAR;
        PG8_WAIT_V(2); PG8_BAR;
        PG8_STAGE(PG8_SB(1, 0), cB + kstep, voffB); PG8_STAGE(PG8_SA(1, 0), cA + kstep, voffA); PG8_STAGE(PG8_SB(1, 1), cB + hstep + kstep, voffB);
        PG8_WAIT_V(6); PG8_BAR;
    } else {
        PG8_STAGE(PG8_SB(0, 0), cB, voffB); PG8_STAGE(PG8_SA(0, 0), cA, voffA); PG8_STAGE(PG8_SB(0, 1), cB + hstep, voffB); PG8_STAGE(PG8_SA(0, 1), cA + hstep, voffA);
        if (wr == 1) PG8_BAR;
        PG8_WAIT_V(4); PG8_BAR;
        PG8_STAGE(PG8_SB(1, 0), cB + kstep, voffB); PG8_STAGE(PG8_SA(1, 0), cA + kstep, voffA); PG8_STAGE(PG8_SB(1, 1), cB + hstep + kstep, voffB);
        PG8_WAIT_V(6); PG8_BAR;
    }
    for (;;) {
        const bool has_next = S.next(ui + 1, nxt);
        const char* nA = has_next ? (const char*)g.A + (size_t)nxt.pm * tstep : cA; const char* nB = has_next ? (const char*)g.Bt + (size_t)nxt.pn * tstep : cB;
        for (int t = 0; t < nt; t += 2) {
            const bool last = (t == nt - 2);
            const char* a1 = cA + (size_t)(t + 1) * kstep;
            const char* a2 = last ? nA : cA + (size_t)(t + 2) * kstep; const char* b2 = last ? nB : cB + (size_t)(t + 2) * kstep;
            const char* a3 = a2 + kstep; const char* b3 = b2 + kstep;
            if (last && has_next) S.a_ready(nxt);
            if constexpr (SP2) {
            PG8_LDB(B0, 0, 0); PG8_LDB(B1, 0, 1); PG8_SCHED; PG8_LDA(At, 0, 0); PG8_STAGE(PG8_SA(1, 1), a1 + hstep, voffA);
            PG8_WAIT_V(8); PG8_WAIT_L(0); PG8_BAR; PG8_MMA(0, 0, At, B0); PG8_MMA(0, 1, At, B1); PG8_BAR; PG8_SCHED;
            PG8_LDA(At, 0, 1); PG8_STAGE(PG8_SB(0, 0), b2, voffB); PG8_STAGE(PG8_SB(0, 1), b2 + hstep, voffB); PG8_STAGE(PG8_SA(0, 0), a2, voffA);
            PG8_WAIT_V(8); PG8_WAIT_L(0); PG8_BAR; PG8_MMA(1, 0, At, B0); PG8_MMA(1, 1, At, B1); PG8_BAR; PG8_SCHED;
            PG8_LDB(B0, 1, 0); PG8_LDB(B1, 1, 1); PG8_SCHED; PG8_LDA(At, 1, 0); PG8_STAGE(PG8_SA(0, 1), a2 + hstep, voffA);
            PG8_WAIT_V(8); PG8_WAIT_L(0); PG8_BAR; PG8_MMA(0, 0, At, B0); PG8_MMA(0, 1, At, B1); PG8_BAR; PG8_SCHED;
            PG8_LDA(At, 1, 1); PG8_STAGE(PG8_SB(1, 0), b3, voffB); PG8_STAGE(PG8_SB(1, 1), b3 + hstep, voffB); PG8_STAGE(PG8_SA(1, 0), a3, voffA);
            PG8_WAIT_V(8); PG8_WAIT_L(0); PG8_BAR; PG8_MMA(1, 0, At, B0); PG8_MMA(1, 1, At, B1); PG8_BAR; PG8_SCHED;
            } else {
            PG8_LDB(B0, 0, 0); PG8_SCHED; PG8_LDA(At, 0, 0); PG8_STAGE(PG8_SA(1, 1), a1 + hstep, voffA);
            PG8_WAIT_L(8); PG8_BAR; PG8_WAIT_L(0); PG8_MMA(0, 0, At, B0); PG8_BAR; PG8_SCHED;
            PG8_LDB(B1, 0, 1); PG8_STAGE(PG8_SB(0, 0), b2, voffB);
            PG8_BAR; PG8_WAIT_L(0); PG8_MMA(0, 1, At, B1); PG8_BAR;
            PG8_LDA(At, 0, 1); PG8_STAGE(PG8_SA(0, 0), a2, voffA);
            PG8_BAR; PG8_WAIT_L(0); PG8_MMA(1, 0, At, B0); PG8_BAR; PG8_SCHED;
            PG8_STAGE(PG8_SB(0, 1), b2 + hstep, voffB);
            PG8_WAIT_V(6); PG8_BAR; PG8_MMA(1, 1, At, B1); PG8_BAR;
            PG8_LDB(B0, 1, 0); PG8_SCHED; PG8_LDA(At, 1, 0); PG8_STAGE(PG8_SA(0, 1), a2 + hstep, voffA);
            PG8_WAIT_L(8); PG8_BAR; PG8_WAIT_L(0); PG8_MMA(0, 0, At, B0); PG8_BAR; PG8_SCHED;
            PG8_LDB(B1, 1, 1); PG8_STAGE(PG8_SB(1, 0), b3, voffB);
            PG8_BAR; PG8_WAIT_L(0); PG8_MMA(0, 1, At, B1); PG8_BAR;
            PG8_LDA(At, 1, 1); PG8_STAGE(PG8_SA(1, 0), a3, voffA);
            PG8_BAR; PG8_WAIT_L(0); PG8_MMA(1, 0, At, B0); PG8_BAR; PG8_SCHED;
            PG8_STAGE(PG8_SB(1, 1), b3 + hstep, voffB);
            PG8_WAIT_V(6); PG8_BAR; PG8_MMA(1, 1, At, B1); PG8_BAR;
            }
        }
        if constexpr (ALIGN_EPI) { if (wr == 0) PG8_BAR; }
        if constexpr (!Epi::AFTER_DRAIN) { E(acc, cur, wr, wc, fr, fq); S.done(cur); }
        if (!has_next) break;
#pragma unroll
        for (int a = 0; a < 2; ++a)
#pragma unroll
            for (int b = 0; b < 2; ++b)
#pragma unroll
                for (int m = 0; m < 4; ++m)
#pragma unroll
                    for (int n = 0; n < 2; ++n) acc[a][b][m][n] = (f32x4){0.f, 0.f, 0.f, 0.f};
        cur = nxt; cA = nA; cB = nB; ++ui;
        if constexpr (ALIGN_EPI) { if (wr == 1) PG8_BAR; }
    }
    PG8_WAIT_V(0);
    if constexpr (!ALIGN_EPI) { if (wr == 0) PG8_BAR; }
    PG8_BAR;
    if constexpr (Epi::AFTER_DRAIN) { E.fused(acc, cur, wr, wc, fr, fq, lds, wid, lane); S.done(cur); }
#undef PG8_SA
#undef PG8_SB
#undef PG8_STAGE
#undef PG8_LDA
#undef PG8_LDB
#undef PG8_MMA
#undef PG8_WAIT_V
#undef PG8_WAIT_L
#undef PG8_BAR
#undef PG8_SCHED
}
}
constexpr int D = 1024, M = 16384, SEQ = 8192, DEPTH = 2;
constexpr int CC = 512, NQ = 8, NKV = 2, HD = 64, AW = 512, WIN = 128;
constexpr int INC = 2304, DFF = 2816, NGU = 2 * DFF;
constexpr int O_Q = 1536, O_K = 2048, O_V = 2176;
constexpr float EPS = 1e-6f, LOG2E = 1.4426950408889634f;
#define LAS __attribute__((address_space(3)))
#define GAS __attribute__((address_space(1)))
typedef unsigned short bf16;
typedef short bf16x8 __attribute__((ext_vector_type(8)));
typedef short s16x4 __attribute__((ext_vector_type(4)));
typedef float f32x4 __attribute__((ext_vector_type(4)));
typedef float f32x16 __attribute__((ext_vector_type(16)));
typedef unsigned u32x4 __attribute__((ext_vector_type(4)));
typedef float f32x2_t __attribute__((ext_vector_type(2))); typedef __bf16 bf16x2_t __attribute__((ext_vector_type(2)));
__device__ __forceinline__ unsigned cvtpk(float lo, float hi) { f32x2_t v = {lo, hi}; bf16x2_t b = __builtin_convertvector(v, bf16x2_t); return __builtin_bit_cast(unsigned, b); }
__device__ __forceinline__ float bf2f(short h) { return __builtin_bit_cast(float, (unsigned)(unsigned short)h << 16); }
__device__ __forceinline__ float bflo(unsigned w) { return __builtin_bit_cast(float, w << 16); }
__device__ __forceinline__ float bfhi(unsigned w) { return __builtin_bit_cast(float, w & 0xffff0000u); }

namespace mixer {
constexpr int LDS_K = 0, LDS_V = 49152, LDS_OST = 98304, LDS_WSF = 131072 + 1024, LDS_SRED = LDS_WSF + 2048;
__device__ __forceinline__ int crow(int r, int hi) { return (r & 3) + 8 * (r >> 2) + 4 * hi; }
__device__ __forceinline__ void qkt(f32x16& p0, f32x16& p1, const LAS unsigned char* Kslot, const bf16x8* qr, int r32, int hi) {
    const LAS unsigned char* kb = Kslot + hi * 1024 + r32 * 16;
    p0 = f32x16{}; p1 = f32x16{};
#pragma unroll
    for (int d0 = 0; d0 < 4; ++d0) {
        const bf16x8 b0 = *(const LAS bf16x8*)(kb + d0 * 2048), b1 = *(const LAS bf16x8*)(kb + d0 * 2048 + 512);
        p0 = __builtin_amdgcn_mfma_f32_32x32x16_bf16(b0, qr[d0], p0, 0, 0, 0);
        p1 = __builtin_amdgcn_mfma_f32_32x32x16_bf16(b1, qr[d0], p1, 0, 0, 0);
    }
}
__device__ __forceinline__ void pv(f32x16* o, int vb, bf16x8 pa0, bf16x8 pa1, bf16x8 pa2, bf16x8 pa3) {
#pragma unroll
    for (int d0 = 0; d0 < 2; ++d0) { s16x4 lo[4], hi[4];
#pragma unroll
        for (int ks = 0; ks < 4; ++ks) {
            asm volatile("ds_read_b64_tr_b16 %0,%1 offset:%c2" : "=&v"(lo[ks]) : "v"(vb), "i"(d0 * 4096 + ks * 1024) : "memory");
            asm volatile("ds_read_b64_tr_b16 %0,%1 offset:%c2" : "=&v"(hi[ks]) : "v"(vb), "i"(d0 * 4096 + ks * 1024 + 512) : "memory"); }
        asm volatile("s_waitcnt lgkmcnt(0)" ::: "memory"); __builtin_amdgcn_sched_barrier(0);
#define MX_PK(k) (bf16x8){lo[k][0], lo[k][1], lo[k][2], lo[k][3], hi[k][0], hi[k][1], hi[k][2], hi[k][3]}
        o[d0] = __builtin_amdgcn_mfma_f32_32x32x16_bf16(pa0, MX_PK(0), o[d0], 0, 0, 0);
        o[d0] = __builtin_amdgcn_mfma_f32_32x32x16_bf16(pa1, MX_PK(1), o[d0], 0, 0, 0);
        o[d0] = __builtin_amdgcn_mfma_f32_32x32x16_bf16(pa2, MX_PK(2), o[d0], 0, 0, 0);
        o[d0] = __builtin_amdgcn_mfma_f32_32x32x16_bf16(pa3, MX_PK(3), o[d0], 0, 0, 0);
#undef MX_PK
    }
}
__device__ __forceinline__ void load_u(const bf16* proj, long tokb, int tt, int c0, float (&u)[8]) {
    if (tt >= 0) { const bf16* pr = proj + (tokb + tt) * INC; const bf16x8 cg = *(const bf16x8*)(pr + CC + c0), hc = *(const bf16x8*)(pr + 2 * CC + c0);
#pragma unroll
        for (int j = 0; j < 8; ++j) u[j] = bf2f(cg[j]) * bf2f(hc[j]); }
    else {
#pragma unroll
        for (int j = 0; j < 8; ++j) u[j] = 0.f; }
}
__device__ __forceinline__ void unit(LAS unsigned char* lds, int un, const bf16* proj, const float* conv_w, const float* qg, const float* kg, const float* sinks, bf16* mix, const int tid) {
    const int lane = tid & 63, wid = __builtin_amdgcn_readfirstlane(tid >> 6), r32 = lane & 31, hi = lane >> 5;
    const int b = un >> 7, t0 = (un & 127) * 64; const long tokb = (long)b * SEQ, tok0 = tokb + t0;
    if (tid < 384) {
        const int kvh = tid / 192, r = tid % 192; int tk = t0 - 128 + r; if (tk < 0) tk = 0;
        const bf16* kr = proj + (tokb + tk) * INC + O_K + kvh * HD;
        bf16x8 c[8]; float ss = 0.f;
#pragma unroll
        for (int i = 0; i < 8; ++i) c[i] = *(const bf16x8*)(kr + 8 * i);
#pragma unroll
        for (int i = 0; i < 8; ++i)
#pragma unroll
            for (int j = 0; j < 8; ++j) { const float f = bf2f(c[i][j]); ss += f * f; }
        const float rs = __builtin_amdgcn_rsqf(ss * (1.0f / HD) + EPS);
        LAS unsigned char* dst = lds + LDS_K + (kvh * 3 + (r >> 6)) * 8192 + (r & 63) * 16;
#pragma unroll
        for (int i = 0; i < 8; ++i) { u32x4 w;
            w.x = cvtpk(bf2f(c[i][0]) * rs * kg[8 * i + 0], bf2f(c[i][1]) * rs * kg[8 * i + 1]); w.y = cvtpk(bf2f(c[i][2]) * rs * kg[8 * i + 2], bf2f(c[i][3]) * rs * kg[8 * i + 3]);
            w.z = cvtpk(bf2f(c[i][4]) * rs * kg[8 * i + 4], bf2f(c[i][5]) * rs * kg[8 * i + 5]); w.w = cvtpk(bf2f(c[i][6]) * rs * kg[8 * i + 6], bf2f(c[i][7]) * rs * kg[8 * i + 7]);
            *(LAS u32x4*)(dst + i * 1024) = w; }
    }
#pragma unroll
    for (int i = 0; i < 6; ++i) { const int it = tid + 512 * i, ch = it & 7, rr = it >> 3, kvh = rr / 192, r = rr % 192; int tk = t0 - 128 + r; if (tk < 0) tk = 0;
        const u32x4 v = *(const u32x4*)(proj + (tokb + tk) * INC + O_V + kvh * HD + ch * 8);
        *(LAS u32x4*)(lds + LDS_V + (kvh * 3 + (r >> 6)) * 8192 + (ch >> 2) * 4096 + (r & 63) * 64 + (ch & 3) * 16) = v; }
    {
        const int c0 = lane * 8; float w0[8], w1[8], w2[8], um2[8], um1[8];
#pragma unroll
        for (int j = 0; j < 8; ++j) { w0[j] = conv_w[c0 + j]; w1[j] = conv_w[CC + c0 + j]; w2[j] = conv_w[2 * CC + c0 + j]; }
        const int tf = t0 + 8 * wid;
        load_u(proj, tokb, tf - 2, c0, um2); load_u(proj, tokb, tf - 1, c0, um1);
#pragma unroll 2
        for (int i = 0; i < 8; ++i) { const bf16* pr = proj + (tokb + tf + i) * INC;
            const bf16x8 bg = *(const bf16x8*)(pr + c0), cg = *(const bf16x8*)(pr + CC + c0), hc = *(const bf16x8*)(pr + 2 * CC + c0);
            float y[8], ss = 0.f;
#pragma unroll
            for (int j = 0; j < 8; ++j) { const float u = bf2f(cg[j]) * bf2f(hc[j]); y[j] = bf2f(bg[j]) * (w0[j] * um2[j] + w1[j] * um1[j] + w2[j] * u); um2[j] = um1[j]; um1[j] = u; ss += y[j] * y[j]; }
#pragma unroll
            for (int o = 1; o < 64; o <<= 1) ss += __shfl_xor(ss, o);
            const float rs = __builtin_amdgcn_rsqf(ss * (1.0f / CC) + EPS);
            u32x4 w; w.x = cvtpk(y[0] * rs, y[1] * rs); w.y = cvtpk(y[2] * rs, y[3] * rs); w.z = cvtpk(y[4] * rs, y[5] * rs); w.w = cvtpk(y[6] * rs, y[7] * rs);
            *(u32x4*)(mix + (tok0 + 8 * wid + i) * D + c0) = w; }
    }
    __syncthreads();
    const int kvh = wid >> 2; const float sink2 = sinks[wid] * LOG2E;
    LAS float* wsf = (LAS float*)(lds + LDS_WSF) + wid * 64;
    LAS float* sred = (LAS float*)(lds + LDS_SRED);
    LAS bf16* stg = (LAS bf16*)(lds + LDS_OST) + wid * 2048;
    const LAS unsigned char* Kh = lds + LDS_K + kvh * 3 * 8192;
    const int vb0 = (int)(unsigned)(uintptr_t)(lds + LDS_V) + kvh * 3 * 8192 + ((lane >> 4) & 1) * 32 + (lane & 3) * 8 + (4 * hi + ((lane & 15) >> 2)) * 64;
#pragma unroll 1
    for (int qb = 0; qb < 2; ++qb) {
        const bf16* qp = proj + (tok0 + 32 * qb + r32) * INC + O_Q + wid * HD + hi * 8;
        bf16x8 qraw[4], qr[4]; float ss = 0.f;
#pragma unroll
        for (int d0 = 0; d0 < 4; ++d0) qraw[d0] = *(const bf16x8*)(qp + 16 * d0);
#pragma unroll
        for (int d0 = 0; d0 < 4; ++d0)
#pragma unroll
            for (int j = 0; j < 8; ++j) { const float f = bf2f(qraw[d0][j]); ss += f * f; }
        ss += __shfl_xor(ss, 32);
        const float qs = __builtin_amdgcn_rsqf(ss * (1.0f / HD) + EPS) * (0.125f * LOG2E);
#pragma unroll
        for (int d0 = 0; d0 < 4; ++d0) { const float* g = qg + 16 * d0 + 8 * hi; u32x4 w;
            w.x = cvtpk(bf2f(qraw[d0][0]) * qs * g[0], bf2f(qraw[d0][1]) * qs * g[1]); w.y = cvtpk(bf2f(qraw[d0][2]) * qs * g[2], bf2f(qraw[d0][3]) * qs * g[3]);
            w.z = cvtpk(bf2f(qraw[d0][4]) * qs * g[4], bf2f(qraw[d0][5]) * qs * g[5]); w.w = cvtpk(bf2f(qraw[d0][6]) * qs * g[6], bf2f(qraw[d0][7]) * qs * g[7]);
            qr[d0] = __builtin_bit_cast(bf16x8, w); }
        f32x16 p[3][2];
#pragma unroll
        for (int T = 0; T < 3; ++T) qkt(p[T][0], p[T][1], Kh + T * 8192, qr, r32, hi);
        const int qrel = 32 * qb + r32 + 128; float mx = sink2;
#pragma unroll
        for (int T = 0; T < 3; ++T)
#pragma unroll
            for (int h2 = 0; h2 < 2; ++h2)
#pragma unroll
                for (int r = 0; r < 16; ++r) { const int kr = 64 * T + 32 * h2 + crow(r, hi), diff = qrel - kr; const bool ok = (diff >= 0) && (diff < WIN) && (t0 - 128 + kr >= 0);
                    const float s = ok ? p[T][h2][r] : -1e30f; p[T][h2][r] = s; mx = fmaxf(mx, s); }
        mx = fmaxf(mx, __shfl_xor(mx, 32));
        float l = 0.f;
#pragma unroll
        for (int T = 0; T < 3; ++T)
#pragma unroll
            for (int h2 = 0; h2 < 2; ++h2)
#pragma unroll
                for (int r = 0; r < 16; ++r) { const float e = __builtin_amdgcn_exp2f(p[T][h2][r] - mx); p[T][h2][r] = e; l += e; }
        l += __shfl_xor(l, 32); l += __builtin_amdgcn_exp2f(sink2 - mx);
        f32x16 o[2]; o[0] = f32x16{}; o[1] = f32x16{};
#pragma unroll
        for (int T = 0; T < 3; ++T) { u32x4 a0, a1, a2, a3;
            a0 = (u32x4){cvtpk(p[T][0][0], p[T][0][1]), cvtpk(p[T][0][2], p[T][0][3]), cvtpk(p[T][0][4], p[T][0][5]), cvtpk(p[T][0][6], p[T][0][7])};
            a1 = (u32x4){cvtpk(p[T][0][8], p[T][0][9]), cvtpk(p[T][0][10], p[T][0][11]), cvtpk(p[T][0][12], p[T][0][13]), cvtpk(p[T][0][14], p[T][0][15])};
            a2 = (u32x4){cvtpk(p[T][1][0], p[T][1][1]), cvtpk(p[T][1][2], p[T][1][3]), cvtpk(p[T][1][4], p[T][1][5]), cvtpk(p[T][1][6], p[T][1][7])};
            a3 = (u32x4){cvtpk(p[T][1][8], p[T][1][9]), cvtpk(p[T][1][10], p[T][1][11]), cvtpk(p[T][1][12], p[T][1][13]), cvtpk(p[T][1][14], p[T][1][15])};
            pv(o, vb0 + T * 8192, __builtin_bit_cast(bf16x8, a0), __builtin_bit_cast(bf16x8, a1), __builtin_bit_cast(bf16x8, a2), __builtin_bit_cast(bf16x8, a3)); }
        if (hi == 0) wsf[r32] = __builtin_amdgcn_rcpf(l);
        asm volatile("s_waitcnt lgkmcnt(0)" ::: "memory");
#pragma unroll
        for (int r = 0; r < 16; ++r) { const float rl = wsf[crow(r, hi)]; o[0][r] *= rl; o[1][r] *= rl; }
#pragma unroll
        for (int r = 0; r < 16; ++r) { const int orow = crow(r, hi); stg[orow * 64 + r32] = (bf16)(cvtpk(o[0][r], 0.f) & 0xffffu); stg[orow * 64 + 32 + r32] = (bf16)(cvtpk(o[1][r], 0.f) & 0xffffu); }
        asm volatile("s_waitcnt lgkmcnt(0)" ::: "memory");
#pragma unroll
        for (int i = 0; i < 4; ++i) { const int row = i * 8 + (lane >> 3); const u32x4 v = *(const LAS u32x4*)(stg + row * 64 + (lane & 7) * 8);
            float s = bflo(v.x) * bflo(v.x) + bfhi(v.x) * bfhi(v.x) + bflo(v.y) * bflo(v.y) + bfhi(v.y) * bfhi(v.y) + bflo(v.z) * bflo(v.z) + bfhi(v.z) * bfhi(v.z) + bflo(v.w) * bflo(v.w) + bfhi(v.w) * bfhi(v.w);
            s += __shfl_xor(s, 1); s += __shfl_xor(s, 2); s += __shfl_xor(s, 4);
            if ((lane & 7) == 0) sred[(qb * 8 + wid) * 32 + row] = s; }
        __syncthreads();
        if (lane < 32) { float tot = 0.f;
#pragma unroll
            for (int h = 0; h < 8; ++h) tot += sred[(qb * 8 + h) * 32 + lane];
            wsf[32 + lane] = __builtin_amdgcn_rsqf(tot * (1.0f / AW) + EPS); }
        asm volatile("s_waitcnt lgkmcnt(0)" ::: "memory");
#pragma unroll
        for (int r = 0; r < 16; ++r) { const int orow = crow(r, hi); const float rn = wsf[32 + orow];
            stg[orow * 64 + r32] = (bf16)(cvtpk(o[0][r] * rn, 0.f) & 0xffffu); stg[orow * 64 + 32 + r32] = (bf16)(cvtpk(o[1][r] * rn, 0.f) & 0xffffu); }
        asm volatile("s_waitcnt lgkmcnt(0)" ::: "memory");
        bf16* Ow = mix + (tok0 + 32 * qb) * D + CC + wid * HD;
#pragma unroll
        for (int i = 0; i < 4; ++i) { const int row = i * 8 + (lane >> 3), ch = lane & 7; const u32x4 v = *(const LAS u32x4*)(stg + row * 64 + ch * 8); *(u32x4*)(Ow + (long)row * D + ch * 8) = v; }
    }
    __syncthreads();
}
}

constexpr size_t MiB = 1u << 20;
constexpr size_t WS_CTL = 0, CTL_BYTES = 320 * 1024;
constexpr size_t WS_RS = 64 * 1024;
constexpr size_t WS_W = 2 * MiB;
constexpr size_t W_IN = 0, W_O = (size_t)INC * D * 2, W_GU = W_O + (size_t)D * D * 2, W_D = W_GU + (size_t)NGU * D * 2, W_LAYER = W_D + (size_t)D * DFF * 2;
constexpr size_t WS_XB = 48 * MiB, WS_PROJ = 80 * MiB, WS_MIX = 152 * MiB, WS_ACT = 80 * MiB, WS_END = 184 * MiB;
static_assert(WS_W + 2 * W_LAYER <= WS_XB && WS_PROJ + (size_t)M * INC * 2 <= WS_MIX && WS_ACT + (size_t)M * DFF * 2 <= WS_END, "d_ws map");
constexpr int CW_BAR = 4096;
constexpr int RING_OFF = 0, RING_BYTES = 131072, LDSCTL_OFF = RING_BYTES, MISC_OFF = LDSCTL_OFF + 320, LDS_BYTES = 147456;
constexpr int NWAVES = 8;

typedef GAS unsigned gu32;
#define RLX_AGENT __ATOMIC_RELAXED, __HIP_MEMORY_SCOPE_AGENT
#define LDS_WAIT() asm volatile("s_waitcnt lgkmcnt(0)" ::: "memory")
__device__ __forceinline__ unsigned f2bf(float f) { unsigned u = __builtin_bit_cast(unsigned, f); return (u + 0x7fffu + ((u >> 16) & 1u)) >> 16; }
__device__ __forceinline__ unsigned pk2(float lo, float hi) { return f2bf(lo) | (f2bf(hi) << 16); }

#define XB_TMO      128
#define XB_XCNT(j)  (256  + 64 * (j))
#define XB_XSUB(j)  (1280 + 64 * (j))
#define XB_XGEN(j)  (2304 + 64 * (j))
#define XB_TOP      3328
#define XB_TOPGEN   3392
#define XCD_BAR_WORDS 3456
#define XB_SPIN_CAP (1u << 18)

__device__ __forceinline__ unsigned xb_ld(unsigned* p)              { return __hip_atomic_load(p, __ATOMIC_RELAXED, __HIP_MEMORY_SCOPE_AGENT); }
__device__ __forceinline__ unsigned xb_add(unsigned* p, unsigned v) { return __hip_atomic_fetch_add(p, v, __ATOMIC_RELAXED, __HIP_MEMORY_SCOPE_AGENT); }
__device__ __forceinline__ unsigned xb_xcc_id() { return (unsigned)__builtin_amdgcn_s_getreg((3 << 11) | 20) & 0xFu; }
#define XB_SPIN(cond, bar) do { unsigned _sp = 0; while (cond) { __builtin_amdgcn_s_sleep(1); \
    if ((++_sp & 255u) == 0u) { if (xb_ld(&(bar)[XB_TMO])) break; if (_sp > XB_SPIN_CAP) { atomicAdd(&(bar)[XB_TMO], 1u); break; } } } } while (0)

struct XcdBarrier {
    unsigned* bar; unsigned x;
    volatile LAS unsigned* st;
};

__device__ __forceinline__ XcdBarrier xcd_barrier_post(unsigned* bar, volatile LAS unsigned* st) {
    XcdBarrier b; b.bar = bar; b.x = xb_xcc_id(); b.st = st;
    if (threadIdx.x == 0) (void)xb_add(&bar[XB_XCNT(b.x)], 1u);
    return b;
}
__device__ __forceinline__ void xcd_barrier_complete(unsigned* bar, unsigned x, unsigned& nloc, unsigned& nx) {
    const unsigned G = gridDim.x * gridDim.y * gridDim.z;
    unsigned sum, cnt, mine, sp = 0u;
    for (;;) {
        sum = 0u; cnt = 0u; mine = 0u;
#pragma unroll
        for (unsigned j = 0; j < 16; ++j) { const unsigned c = xb_ld(&bar[XB_XCNT(j)]); sum += c; cnt += (c > 0u) ? 1u : 0u; mine = (j == x) ? c : mine; }
        if (sum == G) break;
        __builtin_amdgcn_s_sleep(1);
        if ((++sp & 255u) == 0u) { if (xb_ld(&bar[XB_TMO])) break; if (sp > XB_SPIN_CAP) { atomicAdd(&bar[XB_TMO], 1u); break; } }
    }
    nloc = mine > 0u ? mine : 1u; nx = cnt > 0u ? cnt : 1u;
}

__device__ __forceinline__ void xcd_barrier(const XcdBarrier& b) {
    asm volatile("s_waitcnt vmcnt(0)" ::: "memory");
    __syncthreads();
    if (threadIdx.x == 0) {
        unsigned* bar = b.bar;
        __builtin_amdgcn_s_waitcnt(0);
        unsigned nloc = b.st[0], nx = b.st[1];
        if (nloc == 0u) { xcd_barrier_complete(bar, b.x, nloc, nx); b.st[0] = nloc; b.st[1] = nx; }
        const unsigned old = xb_add(&bar[XB_XSUB(b.x)], 1u);
        const unsigned gen = old / nloc;
        if (old + 1u == (gen + 1u) * nloc) {
            __builtin_amdgcn_fence(__ATOMIC_RELEASE, "agent");
            asm volatile("s_waitcnt vmcnt(0)" ::: "memory");
            const unsigned og = xb_add(&bar[XB_TOP], 1u);
            const unsigned tg = og / nx;
            if (og + 1u == (tg + 1u) * nx) xb_add(&bar[XB_TOPGEN], 1u);
            else XB_SPIN(xb_ld(&bar[XB_TOPGEN]) == tg, bar);
            __builtin_amdgcn_fence(__ATOMIC_ACQUIRE, "agent");
            xb_add(&bar[XB_XGEN(b.x)], 1u);
            asm volatile("s_waitcnt vmcnt(0)" ::: "memory");
        } else {
            XB_SPIN(xb_ld(&bar[XB_XGEN(b.x)]) == gen, bar);
            __builtin_amdgcn_fence(__ATOMIC_ACQUIRE, "agent");
            asm volatile("s_waitcnt vmcnt(0)" ::: "memory");
        }
    }
    __syncthreads();
}

__device__ __forceinline__ void p0_transpose_item(const float* W, int K, int N, bf16* WT, int mode, const float* g0, const float* g1, int gsplit, LAS float* scr, int item, int lane) {
    const int nblk = N / 32, kb = item / nblk, nb = item % nblk, k0 = 64 * kb, n0 = 32 * nb;
#pragma unroll 8
    for (int i = 0; i < 32; ++i) { const int kk = 2 * i + (lane >> 5), k = k0 + kk; float gv = 1.f; if (g0) gv = (k < gsplit) ? g0[k] : g1[k - gsplit];
        scr[kk * 33 + (lane & 31)] = W[(size_t)k * N + n0 + (lane & 31)] * gv; }
    LDS_WAIT(); asm volatile("" ::: "memory");
    const int c = lane & 7; int r0 = n0; if (mode) r0 = (n0 / 128) * 256 + (n0 % 128) + (mode == 2 ? 128 : 0);
#pragma unroll
    for (int j = 0; j < 4; ++j) { const int n = (lane >> 3) + 8 * j; const LAS float* s = scr + (8 * c) * 33 + n;
        u32x4 o; o.x = pk2(s[0 * 33], s[1 * 33]); o.y = pk2(s[2 * 33], s[3 * 33]); o.z = pk2(s[4 * 33], s[5 * 33]); o.w = pk2(s[6 * 33], s[7 * 33]);
        *(GAS u32x4*)(WT + (size_t)(r0 + n) * K + k0 + 8 * c) = o; }
    LDS_WAIT(); asm volatile("" ::: "memory");
}
__device__ __forceinline__ void x_row(const float* xrow, bf16* orow, float* rs, int lane) {
    const GAS f32x4* xr = (const GAS f32x4*)xrow + lane; float s = 0.f; f32x4 v[4];
#pragma unroll
    for (int j = 0; j < 4; ++j) { v[j] = xr[64 * j]; s += (v[j].x * v[j].x + v[j].y * v[j].y) + (v[j].z * v[j].z + v[j].w * v[j].w); }
#pragma unroll
    for (int o = 1; o < 64; o <<= 1) s += __shfl_xor(s, o);
    GAS unsigned long long* o8 = (GAS unsigned long long*)orow + lane;
#pragma unroll
    for (int j = 0; j < 4; ++j) o8[64 * j] = (unsigned long long)pk2(v[j].x, v[j].y) | ((unsigned long long)pk2(v[j].z, v[j].w) << 32);
    if (lane == 0) *rs = s;
}

__device__ __forceinline__ int opq_tid() { int t = threadIdx.x; asm volatile("" : "+v"(t)); return t; }
#define OPQ_TID() opq_tid()
struct Args { const float* in[14]; float* out; unsigned char* ws; };
__global__ void __launch_bounds__(NWAVES * 64, 2) hymba_fwd(Args args) {
    extern __shared__ __attribute__((aligned(16))) unsigned char lds_raw[];
    LAS unsigned char* lds = (LAS unsigned char*)lds_raw;
    volatile LAS unsigned* MISC = (volatile LAS unsigned*)(lds + MISC_OFF);
    const int tid = threadIdx.x, lane = tid & 63, wave = __builtin_amdgcn_readfirstlane(tid >> 6);
    const int G = gridDim.x, bx = blockIdx.x, vcu = (G % 8 == 0) ? (bx % 8) * (G / 8) + bx / 8 : bx;
    unsigned char* ws = args.ws;
    gu32* ctl = (gu32*)(ws + WS_CTL);
    const float* x = args.in[0]; float* out = args.out;
    float* RS = (float*)(ws + WS_RS);
    bf16* XB = (bf16*)(ws + WS_XB); bf16* PROJ = (bf16*)(ws + WS_PROJ); bf16* MIX = (bf16*)(ws + WS_MIX); bf16* ACT = (bf16*)(ws + WS_ACT);
    for (int u = tid; u < (LDS_BYTES - LDSCTL_OFF) / 4; u += NWAVES * 64) ((LAS unsigned*)(lds + LDSCTL_OFF))[u] = 0u;
    __syncthreads();
    XcdBarrier bar = xcd_barrier_post((unsigned*)(ctl + CW_BAR), MISC + 8);

    {
        LAS float* scr = (LAS float*)(lds + RING_OFF + wave * 16384);
        const int gw = vcu * NWAVES + wave, NGW = G * NWAVES;
        for (int m = gw; m < M; m += NGW) x_row(x + (size_t)m * D, XB + (size_t)m * D, RS + m, lane);
        constexpr int I_IN = (D / 64) * (INC / 32), I_O = (D / 64) * (D / 32), I_G = (D / 64) * (DFF / 32), I_D = (DFF / 64) * (D / 32), I_L = I_IN + I_O + 2 * I_G + I_D;
        for (int it = gw; it < DEPTH * I_L; it += NGW) {
            const int l = it / I_L; int r = it % I_L; unsigned char* wl = ws + WS_W + l * W_LAYER;
            if (r < I_IN) { p0_transpose_item(args.in[2] + (size_t)l * D * INC, D, INC, (bf16*)(wl + W_IN), 0, args.in[1] + l * D, args.in[1] + l * D, D, scr, r, lane); continue; } r -= I_IN;
            if (r < I_O) { p0_transpose_item(args.in[9] + (size_t)l * D * D, D, D, (bf16*)(wl + W_O), 0, args.in[7] + l * CC, args.in[8] + l * AW, CC, scr, r, lane); continue; } r -= I_O;
            if (r < I_G) { p0_transpose_item(args.in[11] + (size_t)l * D * DFF, D, DFF, (bf16*)(wl + W_GU), 1, args.in[10] + l * D, args.in[10] + l * D, D, scr, r, lane); continue; } r -= I_G;
            if (r < I_G) { p0_transpose_item(args.in[12] + (size_t)l * D * DFF, D, DFF, (bf16*)(wl + W_GU), 2, args.in[10] + l * D, args.in[10] + l * D, D, scr, r, lane); continue; } r -= I_G;
            p0_transpose_item(args.in[13] + (size_t)l * DFF * D, DFF, D, (bf16*)(wl + W_D), 0, nullptr, nullptr, 0, scr, r, lane);
        }
    }
    xcd_barrier(bar);

#pragma unroll 1
    for (int l = 0; l < DEPTH; ++l) {
        unsigned char* wl = ws + WS_W + l * W_LAYER;
        float* rs1 = RS + (size_t)M * (2 * l), *rs2 = RS + (size_t)M * (2 * l + 1), *rs_next = RS + (size_t)M * (2 * l + 2);
        { pg8::Gemm g{XB, (const bf16*)(wl + W_IN), M, INC, D}; pg8::StaticOrder S; S.init(M, INC, G, bx);
          pg8::EpiProj E{PROJ, INC, rs1};
          pg8::gemm_phase<pg8::EpiProj, pg8::StaticOrder, true, true>(lds + RING_OFF, g, S, E, OPQ_TID()); }
        xcd_barrier(bar);
        for (int un = vcu; un < M / 64; un += G)
            mixer::unit(lds, un, PROJ, args.in[3] + l * 3 * CC, args.in[4] + l * HD, args.in[5] + l * HD, args.in[6] + l * NQ, MIX, OPQ_TID());
        xcd_barrier(bar);
        { pg8::Gemm g{MIX, (const bf16*)(wl + W_O), M, D, D}; pg8::StaticOrder S; S.init(M, D, G, bx);
          pg8::EpiRes E{l == 0 ? x : out, out, XB, rs2};
          pg8::gemm_phase<pg8::EpiRes, pg8::StaticOrder, true, true>(lds + RING_OFF, g, S, E, OPQ_TID()); }
        xcd_barrier(bar);
        { pg8::Gemm g{XB, (const bf16*)(wl + W_GU), M, NGU, D}; pg8::StaticOrder S; S.init(M, NGU, G, bx);
          pg8::EpiGU E{ACT, DFF, rs2};
          pg8::gemm_phase<pg8::EpiGU, pg8::StaticOrder, true, true>(lds + RING_OFF, g, S, E, OPQ_TID()); }
        xcd_barrier(bar);
        { pg8::Gemm g{ACT, (const bf16*)(wl + W_D), M, D, DFF}; pg8::StaticOrder S; S.init(M, D, G, bx);
          pg8::EpiRes E{out, out, l + 1 < DEPTH ? XB : nullptr, rs_next};
          pg8::gemm_phase<pg8::EpiRes, pg8::StaticOrder, true, true>(lds + RING_OFF, g, S, E, OPQ_TID()); }
        if (l + 1 < DEPTH) xcd_barrier(bar);
    }
}

extern "C" void kernel_launch(void* const* d_in, const int* in_sizes, int n_in, void* d_out, int out_size, void* d_ws, size_t ws_size, hipStream_t stream) {
    static int grid = 0;
    if (grid == 0) {
        if (n_in != 14 || in_sizes[0] != M * D || out_size != M * D || ws_size < WS_END) { fprintf(stderr, "kernel_launch: unexpected shapes (n_in %d, out %d, ws %zu); nothing launched\n", n_in, out_size, ws_size); grid = -1; return; }
        int dev = 0, cus = 0, per_cu = 0;
        if (hipGetDevice(&dev) != hipSuccess || hipDeviceGetAttribute(&cus, hipDeviceAttributeMultiprocessorCount, dev) != hipSuccess) { grid = -1; return; }
        if (hipFuncSetAttribute((const void*)hymba_fwd, hipFuncAttributeMaxDynamicSharedMemorySize, LDS_BYTES) != hipSuccess) { fprintf(stderr, "kernel_launch: hipFuncSetAttribute failed\n"); grid = -1; return; }
        if (hipOccupancyMaxActiveBlocksPerMultiprocessor(&per_cu, (const void*)hymba_fwd, NWAVES * 64, LDS_BYTES) != hipSuccess || per_cu < 1) { fprintf(stderr, "kernel_launch: occupancy query says %d\n", per_cu); per_cu = 1; }
        (void)hipGetLastError();
        grid = cus * (per_cu < 1 ? 1 : 1);
    }
    if (grid < 0) return;
    if (hipMemsetAsync((char*)d_ws + WS_CTL, 0, CTL_BYTES, stream) != hipSuccess) { fprintf(stderr, "kernel_launch: memset failed\n"); return; }
    Args a{};
    for (int i = 0; i < 14; ++i) a.in[i] = (const float*)d_in[i];
    a.out = (float*)d_out; a.ws = (unsigned char*)d_ws;
    hipLaunchKernelGGL(hymba_fwd, dim3(grid), dim3(NWAVES * 64), LDS_BYTES, stream, a);
    const hipError_t le = hipPeekAtLastError();
    if (le != hipSuccess) fprintf(stderr, "kernel_launch: launch failed: %s\n", hipGetErrorName(le));
}
```

```cpp
#include <hip/hip_runtime.h>
#include <cstdio>
#include <cstdint>

namespace pg8 {
#define PG8_LAS __attribute__((address_space(3)))
typedef unsigned short bf16_t;
typedef short bf16x8 __attribute__((ext_vector_type(8)));
typedef float f32x4 __attribute__((ext_vector_type(4)));
typedef unsigned u32x4 __attribute__((ext_vector_type(4)));
constexpr int BM = 256, BK = 64, HALF = 128, HTB = HALF * BK * 2  , STAGE_BYTES = 8 * HTB, NXCD = 8, WGM = 8;

__host__ __device__ __forceinline__ int lds_byte(int r, int c) { const int st = (r >> 4) * 2 + (c >> 5), rr = r & 15, cc = c & 31, ob = rr * 64 + cc * 2; return st * 1024 + (ob ^ (((ob >> 9) & 1) << 5)); }
__host__ __device__ __forceinline__ void stage_rc(int b, int& R, int& C) { const int st = b / 1024, sb = b % 1024, swz = sb ^ (((sb >> 9) & 1) << 5); R = (st >> 1) * 16 + swz / 64; C = (st & 1) * 32 + (swz % 64) / 2; }
__host__ __device__ __forceinline__ int perm32(int rho) { const int n = rho >> 4, i = rho & 15; return 8 * (i >> 2) + 4 * n + (i & 3); }

struct Unit { int pm, pn; };
struct Gemm { const bf16_t* A; const bf16_t* Bt; int M, N, K; };

struct StaticOrder {
    int nM, nN, nwg, G, c;
    __host__ __device__ void init(int M, int N, int G_, int c_) { nM = M / BM; nN = N / BM; nwg = nM * nN; G = G_; c = c_; }
    __host__ __device__ bool next(int i, Unit& u) const {
        const long L = (long)i * G + c; if (L >= nwg) return false;
        int wgid = (int)L; { const int q = nwg / NXCD, r = nwg % NXCD, xcd = wgid % NXCD, off = wgid / NXCD; wgid = (xcd < r ? xcd * (q + 1) : r * (q + 1) + (xcd - r) * q) + off; }
        const int nig = WGM * nN, gid = wgid / nig, fm = gid * WGM, gsz = (nM - fm) < WGM ? (nM - fm) : WGM;
        u.pm = fm + ((wgid % nig) % gsz); u.pn = (wgid % nig) / gsz; return true;
    }
    __device__ __forceinline__ void a_ready(const Unit&) const {}
    __device__ __forceinline__ void done(const Unit&) const {}
};

__device__ __forceinline__ unsigned cvt_pk_bf16(float lo, float hi) { unsigned r; asm volatile("v_cvt_pk_bf16_f32 %0, %1, %2" : "=v"(r) : "v"(lo), "v"(hi)); return r; }
constexpr float RMS_EPS = 1e-6f;
__device__ __forceinline__ float row_rs(const float* rowss, int row) { return __builtin_amdgcn_rsqf(rowss[row] * (1.0f / 1024.0f) + RMS_EPS); }
struct EpiProj {
    static constexpr bool PERM = true, AFTER_DRAIN = false;
    bf16_t* O; int ldc; const float* rowss;
    __device__ __forceinline__ void operator()(const f32x4 (&acc)[2][2][4][2], const Unit& u, int wr, int wc, int fr, int fq) const {
        const int row0 = u.pm * BM + wr * 64 + fr, col0 = u.pn * BM + wc * 32 + 8 * fq;
#pragma unroll
        for (int ai = 0; ai < 2; ++ai)
#pragma unroll
            for (int m = 0; m < 4; ++m) { const int row = row0 + ai * HALF + m * 16; const float rs = row_rs(rowss, row); bf16_t* rowp = O + (size_t)row * ldc + col0;
#pragma unroll
                for (int bj = 0; bj < 2; ++bj) { const f32x4 v0 = acc[ai][bj][m][0] * rs, v1 = acc[ai][bj][m][1] * rs;
                    u32x4 w; w.x = cvt_pk_bf16(v0[0], v0[1]); w.y = cvt_pk_bf16(v0[2], v0[3]); w.z = cvt_pk_bf16(v1[0], v1[1]); w.w = cvt_pk_bf16(v1[2], v1[3]);
                    *(u32x4*)(rowp + bj * HALF) = w; } }
    }
};
__device__ __forceinline__ float swiglu1(float g, float u) { return g * u * __builtin_amdgcn_rcpf(1.0f + __builtin_amdgcn_exp2f(g * -1.4426950408889634f)); }
struct EpiGU {
    static constexpr bool PERM = true, AFTER_DRAIN = false;
    bf16_t* O; int ldc; const float* rowss;
    __device__ __forceinline__ void operator()(const f32x4 (&acc)[2][2][4][2], const Unit& u, int wr, int wc, int fr, int fq) const {
        const int row0 = u.pm * BM + wr * 64 + fr, col0 = u.pn * HALF + wc * 32 + 8 * fq;
#pragma unroll
        for (int ai = 0; ai < 2; ++ai)
#pragma unroll
            for (int m = 0; m < 4; ++m) { const int row = row0 + ai * HALF + m * 16; const float rs = row_rs(rowss, row);
                const f32x4 g0 = acc[ai][0][m][0] * rs, g1 = acc[ai][0][m][1] * rs, u0 = acc[ai][1][m][0] * rs, u1 = acc[ai][1][m][1] * rs;
                u32x4 w; w.x = cvt_pk_bf16(swiglu1(g0[0], u0[0]), swiglu1(g0[1], u0[1])); w.y = cvt_pk_bf16(swiglu1(g0[2], u0[2]), swiglu1(g0[3], u0[3]));
                w.z = cvt_pk_bf16(swiglu1(g1[0], u1[0]), swiglu1(g1[1], u1[1])); w.w = cvt_pk_bf16(swiglu1(g1[2], u1[2]), swiglu1(g1[3], u1[3]));
                *(u32x4*)(O + (size_t)row * ldc + col0) = w; }
    }
};
struct EpiRes {
    static constexpr bool PERM = true, AFTER_DRAIN = false;
    const float* resf; const bf16_t* resb; float* outf; bf16_t* outb; float* rowss_next;
    __device__ __forceinline__ void operator()(const f32x4 (&acc)[2][2][4][2], const Unit& u, int wr, int wc, int fr, int fq) const {
        const int row0 = u.pm * BM + wr * 64 + fr, col0 = u.pn * BM + wc * 32 + 8 * fq;
#pragma unroll
        for (int ai = 0; ai < 2; ++ai)
#pragma unroll
            for (int m = 0; m < 4; ++m) { const int row = row0 + ai * HALF + m * 16; const size_t off = (size_t)row * 1024 + col0; float ss = 0.f;
#pragma unroll
                for (int bj = 0; bj < 2; ++bj) { f32x4 r0, r1;
                    if (resf) { r0 = *(const f32x4*)(resf + off + bj * HALF); r1 = *(const f32x4*)(resf + off + bj * HALF + 4); }
                    else { const u32x4 w = *(const u32x4*)(resb + off + bj * HALF);
                        r0 = (f32x4){__builtin_bit_cast(float, w.x << 16), __builtin_bit_cast(float, w.x & 0xffff0000u), __builtin_bit_cast(float, w.y << 16), __builtin_bit_cast(float, w.y & 0xffff0000u)};
                        r1 = (f32x4){__builtin_bit_cast(float, w.z << 16), __builtin_bit_cast(float, w.z & 0xffff0000u), __builtin_bit_cast(float, w.w << 16), __builtin_bit_cast(float, w.w & 0xffff0000u)}; }
                    const f32x4 v0 = r0 + acc[ai][bj][m][0], v1 = r1 + acc[ai][bj][m][1];
                    if (outf) { *(f32x4*)(outf + off + bj * HALF) = v0; *(f32x4*)(outf + off + bj * HALF + 4) = v1; }
                    if (outb) { u32x4 w; w.x = cvt_pk_bf16(v0[0], v0[1]); w.y = cvt_pk_bf16(v0[2], v0[3]); w.z = cvt_pk_bf16(v1[0], v1[1]); w.w = cvt_pk_bf16(v1[2], v1[3]);
                        *(u32x4*)(outb + off + bj * HALF) = w; }
                    if (rowss_next) ss += (v0[0] * v0[0] + v0[1] * v0[1]) + (v0[2] * v0[2] + v0[3] * v0[3]) + (v1[0] * v1[0] + v1[1] * v1[1]) + (v1[2] * v1[2] + v1[3] * v1[3]); }
                if (rowss_next) { ss += __shfl_xor(ss, 16); ss += __shfl_xor(ss, 32); if (fq == 0) atomicAdd(rowss_next + row, ss); } }
    }
};

template <class Epi, class Sched, bool ALIGN_EPI = false, bool SP2 = false>
__device__ __forceinline__ void gemm_phase(PG8_LAS unsigned char* lds, const Gemm g, const Sched& S, const Epi& E, const int tid) {
    const int  wid = __builtin_amdgcn_readfirstlane(tid >> 6), lane = tid & 63, wr = wid >> 2, wc = wid & 3, fr = lane & 15, fq = lane >> 4;
    const int K = g.K, nt = K / BK;
    unsigned voffA[2], voffB[2];
#pragma unroll
    for (int i = 0; i < 2; ++i) { int R, C; stage_rc(tid * 16 + i * 8192, R, C); const int Rb = Epi::PERM ? ((R & ~31) + perm32(R & 31)) : R;
        voffA[i] = (unsigned)(R * K + C) * 2u; voffB[i] = (unsigned)(Rb * K + C) * 2u; }
    const size_t kstep = (size_t)(BK * 2);
    const size_t hstep = (size_t)HALF * K * 2;
    const size_t tstep = 2 * hstep;
    const unsigned ldsw = (unsigned)wid * 1024u;
    const int aoff = lds_byte(wr * 64 + fr, fq * 8), boff = lds_byte(wc * 32 + fr, fq * 8);
#define PG8_SA(b, h) (((b) * 2 + (h)) * HTB)
#define PG8_SB(b, h) ((4 + (b) * 2 + (h)) * HTB)
#define PG8_STAGE(bufoff, gbase, voff) do { _Pragma("unroll") for (int _i = 0; _i < 2; ++_i) \
        __builtin_amdgcn_global_load_lds((const unsigned*)((const char*)(gbase) + (voff)[_i]), (PG8_LAS unsigned*)(lds + (bufoff) + ldsw + _i * 8192), 16, 0, 0); } while (0)
#define PG8_LDA(dst, b, h) do { _Pragma("unroll") for (int m = 0; m < 4; ++m) _Pragma("unroll") for (int k = 0; k < 2; ++k) dst[m][k] = *(const PG8_LAS bf16x8*)(lds + PG8_SA(b, h) + aoff + m * 2048 + k * 1024); } while (0)
#define PG8_LDB(dst, b, h) do { _Pragma("unroll") for (int n = 0; n < 2; ++n) _Pragma("unroll") for (int k = 0; k < 2; ++k) dst[n][k] = *(const PG8_LAS bf16x8*)(lds + PG8_SB(b, h) + boff + n * 2048 + k * 1024); } while (0)
#define PG8_MMA(ai, bj, At, Bt) do { __builtin_amdgcn_s_setprio(1); _Pragma("unroll") for (int m = 0; m < 4; ++m) _Pragma("unroll") for (int n = 0; n < 2; ++n) _Pragma("unroll") for (int k = 0; k < 2; ++k) \
        acc[ai][bj][m][n] = __builtin_amdgcn_mfma_f32_16x16x32_bf16(Bt[n][k], At[m][k], acc[ai][bj][m][n], 0, 0, 0); __builtin_amdgcn_s_setprio(0); } while (0)
#define PG8_WAIT_V(n) asm volatile("s_waitcnt vmcnt(" #n ")" ::: "memory")
#define PG8_WAIT_L(n) asm volatile("s_waitcnt lgkmcnt(" #n ")" ::: "memory")
#define PG8_BAR __builtin_amdgcn_s_barrier()
#define PG8_SCHED __builtin_amdgcn_sched_barrier(0)
    Unit cur, nxt; int ui = 0;
    if (!S.next(0, cur)) return;
    f32x4 acc[2][2][4][2];
#pragma unroll
    for (int a = 0; a < 2; ++a)
#pragma unroll
        for (int b = 0; b < 2; ++b)
#pragma unroll
            for (int m = 0; m < 4; ++m)
#pragma unroll
                for (int n = 0; n < 2; ++n) acc[a][b][m][n] = (f32x4){0.f, 0.f, 0.f, 0.f};
    bf16x8 At[4][2], B0[2][2], B1[2][2];
    const char* cA = (const char*)g.A + (size_t)cur.pm * tstep; const char* cB = (const char*)g.Bt + (size_t)cur.pn * tstep;
    S.a_ready(cur);
    if constexpr (SP2) {
        PG8_STAGE(PG8_SB(0, 0), cB, voffB); PG8_STAGE(PG8_SB(0, 1), cB + hstep, voffB); PG8_STAGE(PG8_SA(0, 0), cA, voffA); PG8_STAGE(PG8_SA(0, 1), cA + hstep, voffA);
        if (wr == 1) PG8_BAR;
        PG8_WAIT_V(2); PG8_BAR;
        PG8_STAGE(PG8_SB(1, 0), cB + kstep, voffB); PG8_STAGE(PG8_SA(1, 0), cA + kstep, voffA); PG8_STAGE(PG8_SB(1, 1), cB + hstep + kstep, voffB);
        PG8_WAIT_V(6); PG8_BAR;
    } else {
        PG8_STAGE(PG8_SB(0, 0), cB, voffB); PG8_STAGE(PG8_SA(0, 0), cA, voffA); PG8_STAGE(PG8_SB(0, 1), cB + hstep, voffB); PG8_STAGE(PG8_SA(0, 1), cA + hstep, voffA);
        if (wr == 1) PG8_BAR;
        PG8_WAIT_V(4); PG8_BAR;
        PG8_STAGE(PG8_SB(1, 0), cB + kstep, voffB); PG8_STAGE(PG8_SA(1, 0), cA + kstep, voffA); PG8_STAGE(PG8_SB(1, 1), cB + hstep + kstep, voffB);
        PG8_WAIT_V(6); PG8_BAR;
    }
    for (;;) {
        const bool has_next = S.next(ui + 1, nxt);
        const char* nA = has_next ? (const char*)g.A + (size_t)nxt.pm * tstep : cA; const char* nB = has_next ? (const char*)g.Bt + (size_t)nxt.pn * tstep : cB;
        for (int t = 0; t < nt; t += 2) {
            const bool last = (t == nt - 2);
            const char* a1 = cA + (size_t)(t + 1) * kstep;
            const char* a2 = last ? nA : cA + (size_t)(t + 2) * kstep; const char* b2 = last ? nB : cB + (size_t)(t + 2) * kstep;
            const char* a3 = a2 + kstep; const char* b3 = b2 + kstep;
            if (last && has_next) S.a_ready(nxt);
            if constexpr (SP2) {
            PG8_LDB(B0, 0, 0); PG8_LDB(B1, 0, 1); PG8_SCHED; PG8_LDA(At, 0, 0); PG8_STAGE(PG8_SA(1, 1), a1 + hstep, voffA);
            PG8_WAIT_V(8); PG8_WAIT_L(0); PG8_BAR; PG8_MMA(0, 0, At, B0); PG8_MMA(0, 1, At, B1); PG8_BAR; PG8_SCHED;
            PG8_LDA(At, 0, 1); PG8_STAGE(PG8_SB(0, 0), b2, voffB); PG8_STAGE(PG8_SB(0, 1), b2 + hstep, voffB); PG8_STAGE(PG8_SA(0, 0), a2, voffA);
            PG8_WAIT_V(8); PG8_WAIT_L(0); PG8_BAR; PG8_MMA(1, 0, At, B0); PG8_MMA(1, 1, At, B1); PG8_BAR; PG8_SCHED;
            PG8_LDB(B0, 1, 0); PG8_LDB(B1, 1, 1); PG8_SCHED; PG8_LDA(At, 1, 0); PG8_STAGE(PG8_SA(0, 1), a2 + hstep, voffA);
            PG8_WAIT_V(8); PG8_WAIT_L(0); PG8_BAR; PG8_MMA(0, 0, At, B0); PG8_MMA(0, 1, At, B1); PG8_BAR; PG8_SCHED;
            PG8_LDA(At, 1, 1); PG8_STAGE(PG8_SB(1, 0), b3, voffB); PG8_STAGE(PG8_SB(1, 1), b3 + hstep, voffB); PG8_STAGE(PG8_SA(1, 0), a3, voffA);
            PG8_WAIT_V(8); PG8_WAIT_L(0); PG8_BAR; PG8_MMA(1, 0, At, B0); PG8_MMA(1, 1, At, B1); PG8_BAR; PG8_SCHED;
            } else {
            PG8_LDB(B0, 0, 0); PG8_SCHED; PG8_LDA(At, 0, 0); PG8_STAGE(PG8_SA(1, 1), a1 + hstep, voffA);
            PG8_WAIT_L(8); PG8_BAR; PG8_WAIT_L(0); PG8_MMA(0, 0, At, B0); PG8_BAR; PG8_SCHED;
            PG8_LDB(B1, 0, 1); PG8_STAGE(PG8_SB(0, 0), b2, voffB);
            PG8_BAR; PG8_WAIT_L(0); PG8_MMA(0, 1, At, B1); PG8_BAR;
            PG8_LDA(At, 0, 1); PG8_STAGE(PG8_SA(0, 0), a2, voffA);
            PG8_BAR; PG8_WAIT_L(0); PG8_MMA(1, 0, At, B0); PG8_BAR; PG8_SCHED;
            PG8_STAGE(PG8_SB(0, 1), b2 + hstep, voffB);
            PG8_WAIT_V(6); PG8_BAR; PG8_MMA(1, 1, At, B1); PG8_BAR;
            PG8_LDB(B0, 1, 0); PG8_SCHED; PG8_LDA(At, 1, 0); PG8_STAGE(PG8_SA(0, 1), a2 + hstep, voffA);
            PG8_WAIT_L(8); PG8_BAR; PG8_WAIT_L(0); PG8_MMA(0, 0, At, B0); PG8_BAR; PG8_SCHED;
            PG8_LDB(B1, 1, 1); PG8_STAGE(PG8_SB(1, 0), b3, voffB);
            PG8_BAR; PG8_WAIT_L(0); PG8_MMA(0, 1, At, B1); PG8_BAR;
            PG8_LDA(At, 1, 1); PG8_STAGE(PG8_SA(1, 0), a3, voffA);
            PG8_BAR; PG8_WAIT_L(0); PG8_MMA(1, 0, At, B0); PG8_BAR; PG8_SCHED;
            PG8_STAGE(PG8_SB(1, 1), b3 + hstep, voffB);
            PG8_WAIT_V(6); PG8_BAR; PG8_MMA(1, 1, At, B1); PG8_BAR;
            }
        }
        if constexpr (ALIGN_EPI) { if (wr == 0) PG8_BAR; }
        if constexpr (!Epi::AFTER_DRAIN) { E(acc, cur, wr, wc, fr, fq); S.done(cur); }
        if (!has_next) break;
#pragma unroll
        for (int a = 0; a < 2; ++a)
#pragma unroll
            for (int b = 0; b < 2; ++b)
#pragma unroll
                for (int m = 0; m < 4; ++m)
#pragma unroll
                    for (int n = 0; n < 2; ++n) acc[a][b][m][n] = (f32x4){0.f, 0.f, 0.f, 0.f};
        cur = nxt; cA = nA; cB = nB; ++ui;
        if constexpr (ALIGN_EPI) { if (wr == 1) PG8_BAR; }
    }
    PG8_WAIT_V(0);
    if constexpr (!ALIGN_EPI) { if (wr == 0) PG8_BAR; }
    PG8_BAR;
    if constexpr (Epi::AFTER_DRAIN) { E.fused(acc, cur, wr, wc, fr, fq, lds, wid, lane); S.done(cur); }
#undef PG8_SA
#undef PG8_SB
#undef PG8_STAGE
#undef PG8_LDA
#undef PG8_LDB
#undef PG8_MMA
#undef PG8_WAIT_V
#undef PG8_WAIT_L
#undef PG8_BAR
#undef PG8_SCHED
}
}
constexpr int D = 1024, M = 16384, SEQ = 8192, DEPTH = 2;
constexpr int CC = 512, NQ = 8, NKV = 2, HD = 64, AW = 512, WIN = 128;
constexpr int INC = 2304, DFF = 2816, NGU = 2 * DFF;
constexpr int O_Q = 1536, O_K = 2048, O_V = 2176;
constexpr float EPS = 1e-6f, LOG2E = 1.4426950408889634f;
#define LAS __attribute__((address_space(3)))
#define GAS __attribute__((address_space(1)))
typedef unsigned short bf16;
typedef short bf16x8 __attribute__((ext_vector_type(8)));
typedef short s16x4 __attribute__((ext_vector_type(4)));
typedef float f32x4 __attribute__((ext_vector_type(4)));
typedef float f32x16 __attribute__((ext_vector_type(16)));
typedef unsigned u32x4 __attribute__((ext_vector_type(4)));
typedef float f32x2_t __attribute__((ext_vector_type(2))); typedef __bf16 bf16x2_t __attribute__((ext_vector_type(2)));
__device__ __forceinline__ unsigned cvtpk(float lo, float hi) { f32x2_t v = {lo, hi}; bf16x2_t b = __builtin_convertvector(v, bf16x2_t); return __builtin_bit_cast(unsigned, b); }
__device__ __forceinline__ float bf2f(short h) { return __builtin_bit_cast(float, (unsigned)(unsigned short)h << 16); }
__device__ __forceinline__ float bflo(unsigned w) { return __builtin_bit_cast(float, w << 16); }
__device__ __forceinline__ float bfhi(unsigned w) { return __builtin_bit_cast(float, w & 0xffff0000u); }

namespace mixer {
constexpr int LDS_K = 0, LDS_V = 49152, LDS_OST = 98304, LDS_WSF = 131072 + 1024, LDS_SRED = LDS_WSF + 2048;
__device__ __forceinline__ int crow(int r, int hi) { return (r & 3) + 8 * (r >> 2) + 4 * hi; }
__device__ __forceinline__ void qkt(f32x16& p0, f32x16& p1, const LAS unsigned char* Kslot, const bf16x8* qr, int r32, int hi) {
    const LAS unsigned char* kb = Kslot + hi * 1024 + r32 * 16;
    p0 = f32x16{}; p1 = f32x16{};
#pragma unroll
    for (int d0 = 0; d0 < 4; ++d0) {
        const bf16x8 b0 = *(const LAS bf16x8*)(kb + d0 * 2048), b1 = *(const LAS bf16x8*)(kb + d0 * 2048 + 512);
        p0 = __builtin_amdgcn_mfma_f32_32x32x16_bf16(b0, qr[d0], p0, 0, 0, 0);
        p1 = __builtin_amdgcn_mfma_f32_32x32x16_bf16(b1, qr[d0], p1, 0, 0, 0);
    }
}
__device__ __forceinline__ void pv(f32x16* o, int vb, bf16x8 pa0, bf16x8 pa1, bf16x8 pa2, bf16x8 pa3) {
#pragma unroll
    for (int d0 = 0; d0 < 2; ++d0) { s16x4 lo[4], hi[4];
#pragma unroll
        for (int ks = 0; ks < 4; ++ks) {
            asm volatile("ds_read_b64_tr_b16 %0,%1 offset:%c2" : "=&v"(lo[ks]) : "v"(vb), "i"(d0 * 4096 + ks * 1024) : "memory");
            asm volatile("ds_read_b64_tr_b16 %0,%1 offset:%c2" : "=&v"(hi[ks]) : "v"(vb), "i"(d0 * 4096 + ks * 1024 + 512) : "memory"); }
        asm volatile("s_waitcnt lgkmcnt(0)" ::: "memory"); __builtin_amdgcn_sched_barrier(0);
#define MX_PK(k) (bf16x8){lo[k][0], lo[k][1], lo[k][2], lo[k][3], hi[k][0], hi[k][1], hi[k][2], hi[k][3]}
        o[d0] = __builtin_amdgcn_mfma_f32_32x32x16_bf16(pa0, MX_PK(0), o[d0], 0, 0, 0);
        o[d0] = __builtin_amdgcn_mfma_f32_32x32x16_bf16(pa1, MX_PK(1), o[d0], 0, 0, 0);
        o[d0] = __builtin_amdgcn_mfma_f32_32x32x16_bf16(pa2, MX_PK(2), o[d0], 0, 0, 0);
        o[d0] = __builtin_amdgcn_mfma_f32_32x32x16_bf16(pa3, MX_PK(3), o[d0], 0, 0, 0);
#undef MX_PK
    }
}
__device__ __forceinline__ void load_u(const bf16* proj, long tokb, int tt, int c0, float (&u)[8]) {
    if (tt >= 0) { const bf16* pr = proj + (tokb + tt) * INC; const bf16x8 cg = *(const bf16x8*)(pr + CC + c0), hc = *(const bf16x8*)(pr + 2 * CC + c0);
#pragma unroll
        for (int j = 0; j < 8; ++j) u[j] = bf2f(cg[j]) * bf2f(hc[j]); }
    else {
#pragma unroll
        for (int j = 0; j < 8; ++j) u[j] = 0.f; }
}
__device__ __forceinline__ void unit(LAS unsigned char* lds, int un, const bf16* proj, const float* conv_w, const float* qg, const float* kg, const float* sinks, bf16* mix, const int tid) {
    const int lane = tid & 63, wid = __builtin_amdgcn_readfirstlane(tid >> 6), r32 = lane & 31, hi = lane >> 5;
    const int b = un >> 7, t0 = (un & 127) * 64; const long tokb = (long)b * SEQ, tok0 = tokb + t0;
    if (tid < 384) {
        const int kvh = tid / 192, r = tid % 192; int tk = t0 - 128 + r; if (tk < 0) tk = 0;
        const bf16* kr = proj + (tokb + tk) * INC + O_K + kvh * HD;
        bf16x8 c[8]; float ss = 0.f;
#pragma unroll
        for (int i = 0; i < 8; ++i) c[i] = *(const bf16x8*)(kr + 8 * i);
#pragma unroll
        for (int i = 0; i < 8; ++i)
#pragma unroll
            for (int j = 0; j < 8; ++j) { const float f = bf2f(c[i][j]); ss += f * f; }
        const float rs = __builtin_amdgcn_rsqf(ss * (1.0f / HD) + EPS);
        LAS unsigned char* dst = lds + LDS_K + (kvh * 3 + (r >> 6)) * 8192 + (r & 63) * 16;
#pragma unroll
        for (int i = 0; i < 8; ++i) { u32x4 w;
            w.x = cvtpk(bf2f(c[i][0]) * rs * kg[8 * i + 0], bf2f(c[i][1]) * rs * kg[8 * i + 1]); w.y = cvtpk(bf2f(c[i][2]) * rs * kg[8 * i + 2], bf2f(c[i][3]) * rs * kg[8 * i + 3]);
            w.z = cvtpk(bf2f(c[i][4]) * rs * kg[8 * i + 4], bf2f(c[i][5]) * rs * kg[8 * i + 5]); w.w = cvtpk(bf2f(c[i][6]) * rs * kg[8 * i + 6], bf2f(c[i][7]) * rs * kg[8 * i + 7]);
            *(LAS u32x4*)(dst + i * 1024) = w; }
    }
#pragma unroll
    for (int i = 0; i < 6; ++i) { const int it = tid + 512 * i, ch = it & 7, rr = it >> 3, kvh = rr / 192, r = rr % 192; int tk = t0 - 128 + r; if (tk < 0) tk = 0;
        const u32x4 v = *(const u32x4*)(proj + (tokb + tk) * INC + O_V + kvh * HD + ch * 8);
        *(LAS u32x4*)(lds + LDS_V + (kvh * 3 + (r >> 6)) * 8192 + (ch >> 2) * 4096 + (r & 63) * 64 + (ch & 3) * 16) = v; }
    {
        const int c0 = lane * 8; float w0[8], w1[8], w2[8], um2[8], um1[8];
#pragma unroll
        for (int j = 0; j < 8; ++j) { w0[j] = conv_w[c0 + j]; w1[j] = conv_w[CC + c0 + j]; w2[j] = conv_w[2 * CC + c0 + j]; }
        const int tf = t0 + 8 * wid;
        load_u(proj, tokb, tf - 2, c0, um2); load_u(proj, tokb, tf - 1, c0, um1);
#pragma unroll 2
        for (int i = 0; i < 8; ++i) { const bf16* pr = proj + (tokb + tf + i) * INC;
            const bf16x8 bg = *(const bf16x8*)(pr + c0), cg = *(const bf16x8*)(pr + CC + c0), hc = *(const bf16x8*)(pr + 2 * CC + c0);
            float y[8], ss = 0.f;
#pragma unroll
            for (int j = 0; j < 8; ++j) { const float u = bf2f(cg[j]) * bf2f(hc[j]); y[j] = bf2f(bg[j]) * (w0[j] * um2[j] + w1[j] * um1[j] + w2[j] * u); um2[j] = um1[j]; um1[j] = u; ss += y[j] * y[j]; }
#pragma unroll
            for (int o = 1; o < 64; o <<= 1) ss += __shfl_xor(ss, o);
            const float rs = __builtin_amdgcn_rsqf(ss * (1.0f / CC) + EPS);
            u32x4 w; w.x = cvtpk(y[0] * rs, y[1] * rs); w.y = cvtpk(y[2] * rs, y[3] * rs); w.z = cvtpk(y[4] * rs, y[5] * rs); w.w = cvtpk(y[6] * rs, y[7] * rs);
            *(u32x4*)(mix + (tok0 + 8 * wid + i) * D + c0) = w; }
    }
    __syncthreads();
    const int kvh = wid >> 2; const float sink2 = sinks[wid] * LOG2E;
    LAS float* wsf = (LAS float*)(lds + LDS_WSF) + wid * 64;
    LAS float* sred = (LAS float*)(lds + LDS_SRED);
    LAS bf16* stg = (LAS bf16*)(lds + LDS_OST) + wid * 2048;
    const LAS unsigned char* Kh = lds + LDS_K + kvh * 3 * 8192;
    const int vb0 = (int)(unsigned)(uintptr_t)(lds + LDS_V) + kvh * 3 * 8192 + ((lane >> 4) & 1) * 32 + (lane & 3) * 8 + (4 * hi + ((lane & 15) >> 2)) * 64;
#pragma unroll 1
    for (int qb = 0; qb < 2; ++qb) {
        const bf16* qp = proj + (tok0 + 32 * qb + r32) * INC + O_Q + wid * HD + hi * 8;
        bf16x8 qraw[4], qr[4]; float ss = 0.f;
#pragma unroll
        for (int d0 = 0; d0 < 4; ++d0) qraw[d0] = *(const bf16x8*)(qp + 16 * d0);
#pragma unroll
        for (int d0 = 0; d0 < 4; ++d0)
#pragma unroll
            for (int j = 0; j < 8; ++j) { const float f = bf2f(qraw[d0][j]); ss += f * f; }
        ss += __shfl_xor(ss, 32);
        const float qs = __builtin_amdgcn_rsqf(ss * (1.0f / HD) + EPS) * (0.125f * LOG2E);
#pragma unroll
        for (int d0 = 0; d0 < 4; ++d0) { const float* g = qg + 16 * d0 + 8 * hi; u32x4 w;
            w.x = cvtpk(bf2f(qraw[d0][0]) * qs * g[0], bf2f(qraw[d0][1]) * qs * g[1]); w.y = cvtpk(bf2f(qraw[d0][2]) * qs * g[2], bf2f(qraw[d0][3]) * qs * g[3]);
            w.z = cvtpk(bf2f(qraw[d0][4]) * qs * g[4], bf2f(qraw[d0][5]) * qs * g[5]); w.w = cvtpk(bf2f(qraw[d0][6]) * qs * g[6], bf2f(qraw[d0][7]) * qs * g[7]);
            qr[d0] = __builtin_bit_cast(bf16x8, w); }
        f32x16 p[3][2];
#pragma unroll
        for (int T = 0; T < 3; ++T) qkt(p[T][0], p[T][1], Kh + T * 8192, qr, r32, hi);
        const int qrel = 32 * qb + r32 + 128; float mx = sink2;
#pragma unroll
        for (int T = 0; T < 3; ++T)
#pragma unroll
            for (int h2 = 0; h2 < 2; ++h2)
#pragma unroll
                for (int r = 0; r < 16; ++r) { const int kr = 64 * T + 32 * h2 + crow(r, hi), diff = qrel - kr; const bool ok = (diff >= 0) && (diff < WIN) && (t0 - 128 + kr >= 0);
                    const float s = ok ? p[T][h2][r] : -1e30f; p[T][h2][r] = s; mx = fmaxf(mx, s); }
        mx = fmaxf(mx, __shfl_xor(mx, 32));
        float l = 0.f;
#pragma unroll
        for (int T = 0; T < 3; ++T)
#pragma unroll
            for (int h2 = 0; h2 < 2; ++h2)
#pragma unroll
                for (int r = 0; r < 16; ++r) { const float e = __builtin_amdgcn_exp2f(p[T][h2][r] - mx); p[T][h2][r] = e; l += e; }
        l += __shfl_xor(l, 32); l += __builtin_amdgcn_exp2f(sink2 - mx);
        f32x16 o[2]; o[0] = f32x16{}; o[1] = f32x16{};
#pragma unroll
        for (int T = 0; T < 3; ++T) { u32x4 a0, a1, a2, a3;
            a0 = (u32x4){cvtpk(p[T][0][0], p[T][0][1]), cvtpk(p[T][0][2], p[T][0][3]), cvtpk(p[T][0][4], p[T][0][5]), cvtpk(p[T][0][6], p[T][0][7])};
            a1 = (u32x4){cvtpk(p[T][0][8], p[T][0][9]), cvtpk(p[T][0][10], p[T][0][11]), cvtpk(p[T][0][12], p[T][0][13]), cvtpk(p[T][0][14], p[T][0][15])};
            a2 = (u32x4){cvtpk(p[T][1][0], p[T][1][1]), cvtpk(p[T][1][2], p[T][1][3]), cvtpk(p[T][1][4], p[T][1][5]), cvtpk(p[T][1][6], p[T][1][7])};
            a3 = (u32x4){cvtpk(p[T][1][8], p[T][1][9]), cvtpk(p[T][1][10], p[T][1][11]), cvtpk(p[T][1][12], p[T][1][13]), cvtpk(p[T][1][14], p[T][1][15])};
            pv(o, vb0 + T * 8192, __builtin_bit_cast(bf16x8, a0), __builtin_bit_cast(bf16x8, a1), __builtin_bit_cast(bf16x8, a2), __builtin_bit_cast(bf16x8, a3)); }
        if (hi == 0) wsf[r32] = __builtin_amdgcn_rcpf(l);
        asm volatile("s_waitcnt lgkmcnt(0)" ::: "memory");
#pragma unroll
        for (int r = 0; r < 16; ++r) { const float rl = wsf[crow(r, hi)]; o[0][r] *= rl; o[1][r] *= rl; }
#pragma unroll
        for (int r = 0; r < 16; ++r) { const int orow = crow(r, hi); stg[orow * 64 + r32] = (bf16)(cvtpk(o[0][r], 0.f) & 0xffffu); stg[orow * 64 + 32 + r32] = (bf16)(cvtpk(o[1][r], 0.f) & 0xffffu); }
        asm volatile("s_waitcnt lgkmcnt(0)" ::: "memory");
#pragma unroll
        for (int i = 0; i < 4; ++i) { const int row = i * 8 + (lane >> 3); const u32x4 v = *(const LAS u32x4*)(stg + row * 64 + (lane & 7) * 8);
            float s = bflo(v.x) * bflo(v.x) + bfhi(v.x) * bfhi(v.x) + bflo(v.y) * bflo(v.y) + bfhi(v.y) * bfhi(v.y) + bflo(v.z) * bflo(v.z) + bfhi(v.z) * bfhi(v.z) + bflo(v.w) * bflo(v.w) + bfhi(v.w) * bfhi(v.w);
            s += __shfl_xor(s, 1); s += __shfl_xor(s, 2); s += __shfl_xor(s, 4);
            if ((lane & 7) == 0) sred[(qb * 8 + wid) * 32 + row] = s; }
        __syncthreads();
        if (lane < 32) { float tot = 0.f;
#pragma unroll
            for (int h = 0; h < 8; ++h) tot += sred[(qb * 8 + h) * 32 + lane];
            wsf[32 + lane] = __builtin_amdgcn_rsqf(tot * (1.0f / AW) + EPS); }
        asm volatile("s_waitcnt lgkmcnt(0)" ::: "memory");
#pragma unroll
        for (int r = 0; r < 16; ++r) { const int orow = crow(r, hi); const float rn = wsf[32 + orow];
            stg[orow * 64 + r32] = (bf16)(cvtpk(o[0][r] * rn, 0.f) & 0xffffu); stg[orow * 64 + 32 + r32] = (bf16)(cvtpk(o[1][r] * rn, 0.f) & 0xffffu); }
        asm volatile("s_waitcnt lgkmcnt(0)" ::: "memory");
        bf16* Ow = mix + (tok0 + 32 * qb) * D + CC + wid * HD;
#pragma unroll
        for (int i = 0; i < 4; ++i) { const int row = i * 8 + (lane >> 3), ch = lane & 7; const u32x4 v = *(const LAS u32x4*)(stg + row * 64 + ch * 8); *(u32x4*)(Ow + (long)row * D + ch * 8) = v; }
    }
    __syncthreads();
}
}

constexpr size_t MiB = 1u << 20;
constexpr size_t WS_CTL = 0, CTL_BYTES = 320 * 1024;
constexpr size_t WS_RS = 64 * 1024;
constexpr size_t WS_W = 2 * MiB;
constexpr size_t W_IN = 0, W_O = (size_t)INC * D * 2, W_GU = W_O + (size_t)D * D * 2, W_D = W_GU + (size_t)NGU * D * 2, W_LAYER = W_D + (size_t)D * DFF * 2;
constexpr size_t WS_XB = 48 * MiB, WS_PROJ = 80 * MiB, WS_MIX = 152 * MiB, WS_ACT = 80 * MiB, WS_END = 184 * MiB;
static_assert(WS_W + 2 * W_LAYER <= WS_XB && WS_PROJ + (size_t)M * INC * 2 <= WS_MIX && WS_ACT + (size_t)M * DFF * 2 <= WS_END, "d_ws map");
constexpr int CW_BAR = 4096;
constexpr int RING_OFF = 0, RING_BYTES = 131072, LDSCTL_OFF = RING_BYTES, MISC_OFF = LDSCTL_OFF + 320, LDS_BYTES = 147456;
constexpr int NWAVES = 8;

typedef GAS unsigned gu32;
#define RLX_AGENT __ATOMIC_RELAXED, __HIP_MEMORY_SCOPE_AGENT
#define LDS_WAIT() asm volatile("s_waitcnt lgkmcnt(0)" ::: "memory")
__device__ __forceinline__ unsigned f2bf(float f) { unsigned u = __builtin_bit_cast(unsigned, f); return (u + 0x7fffu + ((u >> 16) & 1u)) >> 16; }
__device__ __forceinline__ unsigned pk2(float lo, float hi) { return f2bf(lo) | (f2bf(hi) << 16); }

#define XB_TMO      128
#define XB_XCNT(j)  (256  + 64 * (j))
#define XB_XSUB(j)  (1280 + 64 * (j))
#define XB_XGEN(j)  (2304 + 64 * (j))
#define XB_TOP      3328
#define XB_TOPGEN   3392
#define XCD_BAR_WORDS 3456
#define XB_SPIN_CAP (1u << 18)

__device__ __forceinline__ unsigned xb_ld(unsigned* p)              { return __hip_atomic_load(p, __ATOMIC_RELAXED, __HIP_MEMORY_SCOPE_AGENT); }
__device__ __forceinline__ unsigned xb_add(unsigned* p, unsigned v) { return __hip_atomic_fetch_add(p, v, __ATOMIC_RELAXED, __HIP_MEMORY_SCOPE_AGENT); }
__device__ __forceinline__ unsigned xb_xcc_id() { return (unsigned)__builtin_amdgcn_s_getreg((3 << 11) | 20) & 0xFu; }
#define XB_SPIN(cond, bar) do { unsigned _sp = 0; while (cond) { __builtin_amdgcn_s_sleep(1); \
    if ((++_sp & 255u) == 0u) { if (xb_ld(&(bar)[XB_TMO])) break; if (_sp > XB_SPIN_CAP) { atomicAdd(&(bar)[XB_TMO], 1u); break; } } } } while (0)

struct XcdBarrier {
    unsigned* bar; unsigned x;
    volatile LAS unsigned* st;
};

__device__ __forceinline__ XcdBarrier xcd_barrier_post(unsigned* bar, volatile LAS unsigned* st) {
    XcdBarrier b; b.bar = bar; b.x = xb_xcc_id(); b.st = st;
    if (threadIdx.x == 0) (void)xb_add(&bar[XB_XCNT(b.x)], 1u);
    return b;
}
__device__ __forceinline__ void xcd_barrier_complete(unsigned* bar, unsigned x, unsigned& nloc, unsigned& nx) {
    const unsigned G = gridDim.x * gridDim.y * gridDim.z;
    unsigned sum, cnt, mine, sp = 0u;
    for (;;) {
        sum = 0u; cnt = 0u; mine = 0u;
#pragma unroll
        for (unsigned j = 0; j < 16; ++j) { const unsigned c = xb_ld(&bar[XB_XCNT(j)]); sum += c; cnt += (c > 0u) ? 1u : 0u; mine = (j == x) ? c : mine; }
        if (sum == G) break;
        __builtin_amdgcn_s_sleep(1);
        if ((++sp & 255u) == 0u) { if (xb_ld(&bar[XB_TMO])) break; if (sp > XB_SPIN_CAP) { atomicAdd(&bar[XB_TMO], 1u); break; } }
    }
    nloc = mine > 0u ? mine : 1u; nx = cnt > 0u ? cnt : 1u;
}

__device__ __forceinline__ void xcd_barrier(const XcdBarrier& b) {
    asm volatile("s_waitcnt vmcnt(0)" ::: "memory");
    __syncthreads();
    if (threadIdx.x == 0) {
        unsigned* bar = b.bar;
        __builtin_amdgcn_s_waitcnt(0);
        unsigned nloc = b.st[0], nx = b.st[1];
        if (nloc == 0u) { xcd_barrier_complete(bar, b.x, nloc, nx); b.st[0] = nloc; b.st[1] = nx; }
        const unsigned old = xb_add(&bar[XB_XSUB(b.x)], 1u);
        const unsigned gen = old / nloc;
        if (old + 1u == (gen + 1u) * nloc) {
            __builtin_amdgcn_fence(__ATOMIC_RELEASE, "agent");
            asm volatile("s_waitcnt vmcnt(0)" ::: "memory");
            const unsigned og = xb_add(&bar[XB_TOP], 1u);
            const unsigned tg = og / nx;
            if (og + 1u == (tg + 1u) * nx) xb_add(&bar[XB_TOPGEN], 1u);
            else XB_SPIN(xb_ld(&bar[XB_TOPGEN]) == tg, bar);
            __builtin_amdgcn_fence(__ATOMIC_ACQUIRE, "agent");
            xb_add(&bar[XB_XGEN(b.x)], 1u);
            asm volatile("s_waitcnt vmcnt(0)" ::: "memory");
        } else {
            XB_SPIN(xb_ld(&bar[XB_XGEN(b.x)]) == gen, bar);
            __builtin_amdgcn_fence(__ATOMIC_ACQUIRE, "agent");
            asm volatile("s_waitcnt vmcnt(0)" ::: "memory");
        }
    }
    __syncthreads();
}

__device__ __forceinline__ void p0_transpose_item(const float* W, int K, int N, bf16* WT, int mode, const float* g0, const float* g1, int gsplit, LAS float* scr, int item, int lane) {
    const int nblk = N / 32, kb = item / nblk, nb = item % nblk, k0 = 64 * kb, n0 = 32 * nb;
#pragma unroll 8
    for (int i = 0; i < 32; ++i) { const int kk = 2 * i + (lane >> 5), k = k0 + kk; float gv = 1.f; if (g0) gv = (k < gsplit) ? g0[k] : g1[k - gsplit];
        scr[kk * 33 + (lane & 31)] = W[(size_t)k * N + n0 + (lane & 31)] * gv; }
    LDS_WAIT(); asm volatile("" ::: "memory");
    const int c = lane & 7; int r0 = n0; if (mode) r0 = (n0 / 128) * 256 + (n0 % 128) + (mode == 2 ? 128 : 0);
#pragma unroll
    for (int j = 0; j < 4; ++j) { const int n = (lane >> 3) + 8 * j; const LAS float* s = scr + (8 * c) * 33 + n;
        u32x4 o; o.x = pk2(s[0 * 33], s[1 * 33]); o.y = pk2(s[2 * 33], s[3 * 33]); o.z = pk2(s[4 * 33], s[5 * 33]); o.w = pk2(s[6 * 33], s[7 * 33]);
        *(GAS u32x4*)(WT + (size_t)(r0 + n) * K + k0 + 8 * c) = o; }
    LDS_WAIT(); asm volatile("" ::: "memory");
}
__device__ __forceinline__ void x_row(const float* xrow, bf16* orow, float* rs, int lane) {
    const GAS f32x4* xr = (const GAS f32x4*)xrow + lane; float s = 0.f; f32x4 v[4];
#pragma unroll
    for (int j = 0; j < 4; ++j) { v[j] = xr[64 * j]; s += (v[j].x * v[j].x + v[j].y * v[j].y) + (v[j].z * v[j].z + v[j].w * v[j].w); }
#pragma unroll
    for (int o = 1; o < 64; o <<= 1) s += __shfl_xor(s, o);
    GAS unsigned long long* o8 = (GAS unsigned long long*)orow + lane;
#pragma unroll
    for (int j = 0; j < 4; ++j) o8[64 * j] = (unsigned long long)pk2(v[j].x, v[j].y) | ((unsigned long long)pk2(v[j].z, v[j].w) << 32);
    if (lane == 0) *rs = s;
}

__device__ __forceinline__ int opq_tid() { int t = threadIdx.x; asm volatile("" : "+v"(t)); return t; }
#define OPQ_TID() opq_tid()
struct Args { const float* in[14]; float* out; unsigned char* ws; };
__global__ void __launch_bounds__(NWAVES * 64, 2) hymba_fwd(Args args) {
    extern __shared__ __attribute__((aligned(16))) unsigned char lds_raw[];
    LAS unsigned char* lds = (LAS unsigned char*)lds_raw;
    volatile LAS unsigned* MISC = (volatile LAS unsigned*)(lds + MISC_OFF);
    const int tid = threadIdx.x, lane = tid & 63, wave = __builtin_amdgcn_readfirstlane(tid >> 6);
    const int G = gridDim.x, bx = blockIdx.x, vcu = (G % 8 == 0) ? (bx % 8) * (G / 8) + bx / 8 : bx;
    unsigned char* ws = args.ws;
    gu32* ctl = (gu32*)(ws + WS_CTL);
    const float* x = args.in[0]; float* out = args.out;
    float* RS = (float*)(ws + WS_RS);
    bf16* XB = (bf16*)(ws + WS_XB); bf16* PROJ = (bf16*)(ws + WS_PROJ); bf16* MIX = (bf16*)(ws + WS_MIX); bf16* ACT = (bf16*)(ws + WS_ACT);
    for (int u = tid; u < (LDS_BYTES - LDSCTL_OFF) / 4; u += NWAVES * 64) ((LAS unsigned*)(lds + LDSCTL_OFF))[u] = 0u;
    __syncthreads();
    XcdBarrier bar = xcd_barrier_post((unsigned*)(ctl + CW_BAR), MISC + 8);

    {
        LAS float* scr = (LAS float*)(lds + RING_OFF + wave * 16384);
        const int gw = vcu * NWAVES + wave, NGW = G * NWAVES;
        for (int m = gw; m < M; m += NGW) x_row(x + (size_t)m * D, XB + (size_t)m * D, RS + m, lane);
        constexpr int I_IN = (D / 64) * (INC / 32), I_O = (D / 64) * (D / 32), I_G = (D / 64) * (DFF / 32), I_D = (DFF / 64) * (D / 32), I_L = I_IN + I_O + 2 * I_G + I_D;
        for (int it = gw; it < DEPTH * I_L; it += NGW) {
            const int l = it / I_L; int r = it % I_L; unsigned char* wl = ws + WS_W + l * W_LAYER;
            if (r < I_IN) { p0_transpose_item(args.in[2] + (size_t)l * D * INC, D, INC, (bf16*)(wl + W_IN), 0, args.in[1] + l * D, args.in[1] + l * D, D, scr, r, lane); continue; } r -= I_IN;
            if (r < I_O) { p0_transpose_item(args.in[9] + (size_t)l * D * D, D, D, (bf16*)(wl + W_O), 0, args.in[7] + l * CC, args.in[8] + l * AW, CC, scr, r, lane); continue; } r -= I_O;
            if (r < I_G) { p0_transpose_item(args.in[11] + (size_t)l * D * DFF, D, DFF, (bf16*)(wl + W_GU), 1, args.in[10] + l * D, args.in[10] + l * D, D, scr, r, lane); continue; } r -= I_G;
            if (r < I_G) { p0_transpose_item(args.in[12] + (size_t)l * D * DFF, D, DFF, (bf16*)(wl + W_GU), 2, args.in[10] + l * D, args.in[10] + l * D, D, scr, r, lane); continue; } r -= I_G;
            p0_transpose_item(args.in[13] + (size_t)l * DFF * D, DFF, D, (bf16*)(wl + W_D), 0, nullptr, nullptr, 0, scr, r, lane);
        }
    }
    xcd_barrier(bar);

#pragma unroll 1
    for (int l = 0; l < DEPTH; ++l) {
        unsigned char* wl = ws + WS_W + l * W_LAYER;
        float* rs1 = RS + (size_t)M * (2 * l), *rs2 = RS + (size_t)M * (2 * l + 1), *rs_next = RS + (size_t)M * (2 * l + 2);
        { pg8::Gemm g{XB, (const bf16*)(wl + W_IN), M, INC, D}; pg8::StaticOrder S; S.init(M, INC, G, bx);
          pg8::EpiProj E{PROJ, INC, rs1};
          pg8::gemm_phase<pg8::EpiProj, pg8::StaticOrder, true, true>(lds + RING_OFF, g, S, E, OPQ_TID()); }
        xcd_barrier(bar);
        for (int un = vcu; un < M / 64; un += G)
            mixer::unit(lds, un, PROJ, args.in[3] + l * 3 * CC, args.in[4] + l * HD, args.in[5] + l * HD, args.in[6] + l * NQ, MIX, OPQ_TID());
        xcd_barrier(bar);
        { pg8::Gemm g{MIX, (const bf16*)(wl + W_O), M, D, D}; pg8::StaticOrder S; S.init(M, D, G, bx);
          pg8::EpiRes E{l == 0 ? x : nullptr, XB, nullptr, XB, rs2};
          pg8::gemm_phase<pg8::EpiRes, pg8::StaticOrder, true, true>(lds + RING_OFF, g, S, E, OPQ_TID()); }
        xcd_barrier(bar);
        { pg8::Gemm g{XB, (const bf16*)(wl + W_GU), M, NGU, D}; pg8::StaticOrder S; S.init(M, NGU, G, bx);
          pg8::EpiGU E{ACT, DFF, rs2};
          pg8::gemm_phase<pg8::EpiGU, pg8::StaticOrder, true, true>(lds + RING_OFF, g, S, E, OPQ_TID()); }
        xcd_barrier(bar);
        { pg8::Gemm g{ACT, (const bf16*)(wl + W_D), M, D, DFF}; pg8::StaticOrder S; S.init(M, D, G, bx);
          pg8::EpiRes E{nullptr, XB, l + 1 < DEPTH ? nullptr : out, l + 1 < DEPTH ? XB : nullptr, l + 1 < DEPTH ? rs_next : nullptr};
          pg8::gemm_phase<pg8::EpiRes, pg8::StaticOrder, true, true>(lds + RING_OFF, g, S, E, OPQ_TID()); }
        if (l + 1 < DEPTH) xcd_barrier(bar);
    }
}

extern "C" void kernel_launch(void* const* d_in, const int* in_sizes, int n_in, void* d_out, int out_size, void* d_ws, size_t ws_size, hipStream_t stream) {
    static int grid = 0;
    if (grid == 0) {
        if (n_in != 14 || in_sizes[0] != M * D || out_size != M * D || ws_size < WS_END) { fprintf(stderr, "kernel_launch: unexpected shapes (n_in %d, out %d, ws %zu); nothing launched\n", n_in, out_size, ws_size); grid = -1; return; }
        int dev = 0, cus = 0, per_cu = 0;
        if (hipGetDevice(&dev) != hipSuccess || hipDeviceGetAttribute(&cus, hipDeviceAttributeMultiprocessorCount, dev) != hipSuccess) { grid = -1; return; }
        if (hipFuncSetAttribute((const void*)hymba_fwd, hipFuncAttributeMaxDynamicSharedMemorySize, LDS_BYTES) != hipSuccess) { fprintf(stderr, "kernel_launch: hipFuncSetAttribute failed\n"); grid = -1; return; }
        if (hipOccupancyMaxActiveBlocksPerMultiprocessor(&per_cu, (const void*)hymba_fwd, NWAVES * 64, LDS_BYTES) != hipSuccess || per_cu < 1) { fprintf(stderr, "kernel_launch: occupancy query says %d\n", per_cu); per_cu = 1; }
        (void)hipGetLastError();
        grid = cus * (per_cu < 1 ? 1 : 1);
    }
    if (grid < 0) return;
    if (hipMemsetAsync((char*)d_ws + WS_CTL, 0, CTL_BYTES, stream) != hipSuccess) { fprintf(stderr, "kernel_launch: memset failed\n"); return; }
    Args a{};
    for (int i = 0; i < 14; ++i) a.in[i] = (const float*)d_in[i];
    a.out = (float*)d_out; a.ws = (unsigned char*)d_ws;
    hipLaunchKernelGGL(hymba_fwd, dim3(grid), dim3(NWAVES * 64), LDS_BYTES, stream, a);
    const hipError_t le = hipPeekAtLastError();
    if (le != hipSuccess) fprintf(stderr, "kernel_launch: launch failed: %s\n", hipGetErrorName(le));
}
```

```cpp
#include <hip/hip_runtime.h>
#include <cstdio>
#include <cstdint>

namespace pg8 {
#define PG8_LAS __attribute__((address_space(3)))
typedef unsigned short bf16_t;
typedef short bf16x8 __attribute__((ext_vector_type(8)));
typedef float f32x4 __attribute__((ext_vector_type(4)));
typedef unsigned u32x4 __attribute__((ext_vector_type(4)));
constexpr int BM = 256, BK = 64, HALF = 128, HTB = HALF * BK * 2  , STAGE_BYTES = 8 * HTB, NXCD = 8, WGM = 8;

__host__ __device__ __forceinline__ int lds_byte(int r, int c) { const int st = (r >> 4) * 2 + (c >> 5), rr = r & 15, cc = c & 31, ob = rr * 64 + cc * 2; return st * 1024 + (ob ^ (((ob >> 9) & 1) << 5)); }
__host__ __device__ __forceinline__ void stage_rc(int b, int& R, int& C) { const int st = b / 1024, sb = b % 1024, swz = sb ^ (((sb >> 9) & 1) << 5); R = (st >> 1) * 16 + swz / 64; C = (st & 1) * 32 + (swz % 64) / 2; }
__host__ __device__ __forceinline__ int perm32(int rho) { const int n = rho >> 4, i = rho & 15; return 8 * (i >> 2) + 4 * n + (i & 3); }

struct Unit { int pm, pn; };
struct Gemm { const bf16_t* A; const bf16_t* Bt; int M, N, K; };

struct StaticOrder {
    int nM, nN, nwg, G, c;
    __host__ __device__ void init(int M, int N, int G_, int c_) { nM = M / BM; nN = N / BM; nwg = nM * nN; G = G_; c = c_; }
    __host__ __device__ bool next(int i, Unit& u) const {
        const long L = (long)i * G + c; if (L >= nwg) return false;
        int wgid = (int)L; { const int q = nwg / NXCD, r = nwg % NXCD, xcd = wgid % NXCD, off = wgid / NXCD; wgid = (xcd < r ? xcd * (q + 1) : r * (q + 1) + (xcd - r) * q) + off; }
        const int nig = WGM * nN, gid = wgid / nig, fm = gid * WGM, gsz = (nM - fm) < WGM ? (nM - fm) : WGM;
        u.pm = fm + ((wgid % nig) % gsz); u.pn = (wgid % nig) / gsz; return true;
    }
    __device__ __forceinline__ void a_ready(const Unit&) const {}
    __device__ __forceinline__ void done(const Unit&) const {}
};

__device__ __forceinline__ unsigned cvt_pk_bf16(float lo, float hi) { unsigned r; asm volatile("v_cvt_pk_bf16_f32 %0, %1, %2" : "=v"(r) : "v"(lo), "v"(hi)); return r; }
constexpr float RMS_EPS = 1e-6f;
__device__ __forceinline__ float row_rs(const float* rowss, int row) { return __builtin_amdgcn_rsqf(rowss[row] * (1.0f / 1024.0f) + RMS_EPS); }
struct EpiProj {
    static constexpr bool PERM = true, AFTER_DRAIN = false;
    bf16_t* O; int ldc; const float* rowss;
    __device__ __forceinline__ void operator()(const f32x4 (&acc)[2][2][4][2], const Unit& u, int wr, int wc, int fr, int fq) const {
        const int row0 = u.pm * BM + wr * 64 + fr, col0 = u.pn * BM + wc * 32 + 8 * fq;
#pragma unroll
        for (int ai = 0; ai < 2; ++ai)
#pragma unroll
            for (int m = 0; m < 4; ++m) { const int row = row0 + ai * HALF + m * 16; const float rs = row_rs(rowss, row); bf16_t* rowp = O + (size_t)row * ldc + col0;
#pragma unroll
                for (int bj = 0; bj < 2; ++bj) { const f32x4 v0 = acc[ai][bj][m][0] * rs, v1 = acc[ai][bj][m][1] * rs;
                    u32x4 w; w.x = cvt_pk_bf16(v0[0], v0[1]); w.y = cvt_pk_bf16(v0[2], v0[3]); w.z = cvt_pk_bf16(v1[0], v1[1]); w.w = cvt_pk_bf16(v1[2], v1[3]);
                    *(u32x4*)(rowp + bj * HALF) = w; } }
    }
};
__device__ __forceinline__ float swiglu1(float g, float u) { return g * u * __builtin_amdgcn_rcpf(1.0f + __builtin_amdgcn_exp2f(g * -1.4426950408889634f)); }
struct EpiGU {
    static constexpr bool PERM = true, AFTER_DRAIN = false;
    bf16_t* O; int ldc; const float* rowss;
    __device__ __forceinline__ void operator()(const f32x4 (&acc)[2][2][4][2], const Unit& u, int wr, int wc, int fr, int fq) const {
        const int row0 = u.pm * BM + wr * 64 + fr, col0 = u.pn * HALF + wc * 32 + 8 * fq;
#pragma unroll
        for (int ai = 0; ai < 2; ++ai)
#pragma unroll
            for (int m = 0; m < 4; ++m) { const int row = row0 + ai * HALF + m * 16; const float rs = row_rs(rowss, row);
                const f32x4 g0 = acc[ai][0][m][0] * rs, g1 = acc[ai][0][m][1] * rs, u0 = acc[ai][1][m][0] * rs, u1 = acc[ai][1][m][1] * rs;
                u32x4 w; w.x = cvt_pk_bf16(swiglu1(g0[0], u0[0]), swiglu1(g0[1], u0[1])); w.y = cvt_pk_bf16(swiglu1(g0[2], u0[2]), swiglu1(g0[3], u0[3]));
                w.z = cvt_pk_bf16(swiglu1(g1[0], u1[0]), swiglu1(g1[1], u1[1])); w.w = cvt_pk_bf16(swiglu1(g1[2], u1[2]), swiglu1(g1[3], u1[3]));
                *(u32x4*)(O + (size_t)row * ldc + col0) = w; }
    }
};
struct EpiRes {
    static constexpr bool PERM = true, AFTER_DRAIN = false;
    const float* resf; const bf16_t* resb; float* outf; bf16_t* outb; float* rowss_next;
    __device__ __forceinline__ void operator()(const f32x4 (&acc)[2][2][4][2], const Unit& u, int wr, int wc, int fr, int fq) const {
        const int row0 = u.pm * BM + wr * 64 + fr, col0 = u.pn * BM + wc * 32 + 8 * fq;
#pragma unroll
        for (int ai = 0; ai < 2; ++ai)
#pragma unroll
            for (int m = 0; m < 4; ++m) { const int row = row0 + ai * HALF + m * 16; const size_t off = (size_t)row * 1024 + col0; float ss = 0.f;
#pragma unroll
                for (int bj = 0; bj < 2; ++bj) { f32x4 r0, r1;
                    if (resf) { r0 = *(const f32x4*)(resf + off + bj * HALF); r1 = *(const f32x4*)(resf + off + bj * HALF + 4); }
                    else { const u32x4 w = *(const u32x4*)(resb + off + bj * HALF);
                        r0 = (f32x4){__builtin_bit_cast(float, w.x << 16), __builtin_bit_cast(float, w.x & 0xffff0000u), __builtin_bit_cast(float, w.y << 16), __builtin_bit_cast(float, w.y & 0xffff0000u)};
                        r1 = (f32x4){__builtin_bit_cast(float, w.z << 16), __builtin_bit_cast(float, w.z & 0xffff0000u), __builtin_bit_cast(float, w.w << 16), __builtin_bit_cast(float, w.w & 0xffff0000u)}; }
                    const f32x4 v0 = r0 + acc[ai][bj][m][0], v1 = r1 + acc[ai][bj][m][1];
                    if (outf) { *(f32x4*)(outf + off + bj * HALF) = v0; *(f32x4*)(outf + off + bj * HALF + 4) = v1; }
                    if (outb) { u32x4 w; w.x = cvt_pk_bf16(v0[0], v0[1]); w.y = cvt_pk_bf16(v0[2], v0[3]); w.z = cvt_pk_bf16(v1[0], v1[1]); w.w = cvt_pk_bf16(v1[2], v1[3]);
                        *(u32x4*)(outb + off + bj * HALF) = w; }
                    if (rowss_next) ss += (v0[0] * v0[0] + v0[1] * v0[1]) + (v0[2] * v0[2] + v0[3] * v0[3]) + (v1[0] * v1[0] + v1[1] * v1[1]) + (v1[2] * v1[2] + v1[3] * v1[3]); }
                if (rowss_next) { ss += __shfl_xor(ss, 16); ss += __shfl_xor(ss, 32); if (fq == 0) atomicAdd(rowss_next + row, ss); } }
    }
};

template <class Epi, class Sched, bool ALIGN_EPI = false, bool SP2 = false>
__device__ __forceinline__ void gemm_phase(PG8_LAS unsigned char* lds, const Gemm g, const Sched& S, const Epi& E, const int tid) {
    const int  wid = __builtin_amdgcn_readfirstlane(tid >> 6), lane = tid & 63, wr = wid >> 2, wc = wid & 3, fr = lane & 15, fq = lane >> 4;
    const int K = g.K, nt = K / BK;
    unsigned voffA[2], voffB[2];
#pragma unroll
    for (int i = 0; i < 2; ++i) { int R, C; stage_rc(tid * 16 + i * 8192, R, C); const int Rb = Epi::PERM ? ((R & ~31) + perm32(R & 31)) : R;
        voffA[i] = (unsigned)(R * K + C) * 2u; voffB[i] = (unsigned)(Rb * K + C) * 2u; }
    const size_t kstep = (size_t)(BK * 2);
    const size_t hstep = (size_t)HALF * K * 2;
    const size_t tstep = 2 * hstep;
    const unsigned ldsw = (unsigned)wid * 1024u;
    const int aoff = lds_byte(wr * 64 + fr, fq * 8), boff = lds_byte(wc * 32 + fr, fq * 8);
#define PG8_SA(b, h) (((b) * 2 + (h)) * HTB)
#define PG8_SB(b, h) ((4 + (b) * 2 + (h)) * HTB)
#define PG8_STAGE(bufoff, gbase, voff) do { _Pragma("unroll") for (int _i = 0; _i < 2; ++_i) \
        __builtin_amdgcn_global_load_lds((const unsigned*)((const char*)(gbase) + (voff)[_i]), (PG8_LAS unsigned*)(lds + (bufoff) + ldsw + _i * 8192), 16, 0, 0); } while (0)
#define PG8_LDA(dst, b, h) do { _Pragma("unroll") for (int m = 0; m < 4; ++m) _Pragma("unroll") for (int k = 0; k < 2; ++k) dst[m][k] = *(const PG8_LAS bf16x8*)(lds + PG8_SA(b, h) + aoff + m * 2048 + k * 1024); } while (0)
#define PG8_LDB(dst, b, h) do { _Pragma("unroll") for (int n = 0; n < 2; ++n) _Pragma("unroll") for (int k = 0; k < 2; ++k) dst[n][k] = *(const PG8_LAS bf16x8*)(lds + PG8_SB(b, h) + boff + n * 2048 + k * 1024); } while (0)
#define PG8_MMA(ai, bj, At, Bt) do { __builtin_amdgcn_s_setprio(1); _Pragma("unroll") for (int m = 0; m < 4; ++m) _Pragma("unroll") for (int n = 0; n < 2; ++n) _Pragma("unroll") for (int k = 0; k < 2; ++k) \
        acc[ai][bj][m][n] = __builtin_amdgcn_mfma_f32_16x16x32_bf16(Bt[n][k], At[m][k], acc[ai][bj][m][n], 0, 0, 0); __builtin_amdgcn_s_setprio(0); } while (0)
#define PG8_WAIT_V(n) asm volatile("s_waitcnt vmcnt(" #n ")" ::: "memory")
#define PG8_WAIT_L(n) asm volatile("s_waitcnt lgkmcnt(" #n ")" ::: "memory")
#define PG8_BAR __builtin_amdgcn_s_barrier()
#define PG8_SCHED __builtin_amdgcn_sched_barrier(0)
    Unit cur, nxt; int ui = 0;
    if (!S.next(0, cur)) return;
    f32x4 acc[2][2][4][2];
#pragma unroll
    for (int a = 0; a < 2; ++a)
#pragma unroll
        for (int b = 0; b < 2; ++b)
#pragma unroll
            for (int m = 0; m < 4; ++m)
#pragma unroll
                for (int n = 0; n < 2; ++n) acc[a][b][m][n] = (f32x4){0.f, 0.f, 0.f, 0.f};
    bf16x8 At[4][2], B0[2][2], B1[2][2];
    const char* cA = (const char*)g.A + (size_t)cur.pm * tstep; const char* cB = (const char*)g.Bt + (size_t)cur.pn * tstep;
    S.a_ready(cur);
    if constexpr (SP2) {
        PG8_STAGE(PG8_SB(0, 0), cB, voffB); PG8_STAGE(PG8_SB(0, 1), cB + hstep, voffB); PG8_STAGE(PG8_SA(0, 0), cA, voffA); PG8_STAGE(PG8_SA(0, 1), cA + hstep, voffA);
        if (wr == 1) PG8_BAR;
        PG8_WAIT_V(2); PG8_BAR;
        PG8_STAGE(PG8_SB(1, 0), cB + kstep, voffB); PG8_STAGE(PG8_SA(1, 0), cA + kstep, voffA); PG8_STAGE(PG8_SB(1, 1), cB + hstep + kstep, voffB);
        PG8_WAIT_V(6); PG8_BAR;
    } else {
        PG8_STAGE(PG8_SB(0, 0), cB, voffB); PG8_STAGE(PG8_SA(0, 0), cA, voffA); PG8_STAGE(PG8_SB(0, 1), cB + hstep, voffB); PG8_STAGE(PG8_SA(0, 1), cA + hstep, voffA);
        if (wr == 1) PG8_BAR;
        PG8_WAIT_V(4); PG8_BAR;
        PG8_STAGE(PG8_SB(1, 0), cB + kstep, voffB); PG8_STAGE(PG8_SA(1, 0), cA + kstep, voffA); PG8_STAGE(PG8_SB(1, 1), cB + hstep + kstep, voffB);
        PG8_WAIT_V(6); PG8_BAR;
    }
    for (;;) {
        const bool has_next = S.next(ui + 1, nxt);
        const char* nA = has_next ? (const char*)g.A + (size_t)nxt.pm * tstep : cA; const char* nB = has_next ? (const char*)g.Bt + (size_t)nxt.pn * tstep : cB;
        for (int t = 0; t < nt; t += 2) {
            const bool last = (t == nt - 2);
            const char* a1 = cA + (size_t)(t + 1) * kstep;
            const char* a2 = last ? nA : cA + (size_t)(t + 2) * kstep; const char* b2 = last ? nB : cB + (size_t)(t + 2) * kstep;
            const char* a3 = a2 + kstep; const char* b3 = b2 + kstep;
            if (last && has_next) S.a_ready(nxt);
            if constexpr (SP2) {
            PG8_LDB(B0, 0, 0); PG8_LDB(B1, 0, 1); PG8_SCHED; PG8_LDA(At, 0, 0); PG8_STAGE(PG8_SA(1, 1), a1 + hstep, voffA);
            PG8_WAIT_V(8); PG8_WAIT_L(0); PG8_BAR; PG8_MMA(0, 0, At, B0); PG8_MMA(0, 1, At, B1); PG8_BAR; PG8_SCHED;
            PG8_LDA(At, 0, 1); PG8_STAGE(PG8_SB(0, 0), b2, voffB); PG8_STAGE(PG8_SB(0, 1), b2 + hstep, voffB); PG8_STAGE(PG8_SA(0, 0), a2, voffA);
            PG8_WAIT_V(8); PG8_WAIT_L(0); PG8_BAR; PG8_MMA(1, 0, At, B0); PG8_MMA(1, 1, At, B1); PG8_BAR; PG8_SCHED;
            PG8_LDB(B0, 1, 0); PG8_LDB(B1, 1, 1); PG8_SCHED; PG8_LDA(At, 1, 0); PG8_STAGE(PG8_SA(0, 1), a2 + hstep, voffA);
            PG8_WAIT_V(8); PG8_WAIT_L(0); PG8_BAR; PG8_MMA(0, 0, At, B0); PG8_MMA(0, 1, At, B1); PG8_BAR; PG8_SCHED;
            PG8_LDA(At, 1, 1); PG8_STAGE(PG8_SB(1, 0), b3, voffB); PG8_STAGE(PG8_SB(1, 1), b3 + hstep, voffB); PG8_STAGE(PG8_SA(1, 0), a3, voffA);
            PG8_WAIT_V(8); PG8_WAIT_L(0); PG8_BAR; PG8_MMA(1, 0, At, B0); PG8_MMA(1, 1, At, B1); PG8_BAR; PG8_SCHED;
            } else {
            PG8_LDB(B0, 0, 0); PG8_SCHED; PG8_LDA(At, 0, 0); PG8_STAGE(PG8_SA(1, 1), a1 + hstep, voffA);
            PG8_WAIT_L(8); PG8_BAR; PG8_WAIT_L(0); PG8_MMA(0, 0, At, B0); PG8_BAR; PG8_SCHED;
            PG8_LDB(B1, 0, 1); PG8_STAGE(PG8_SB(0, 0), b2, voffB);
            PG8_BAR; PG8_WAIT_L(0); PG8_MMA(0, 1, At, B1); PG8_BAR;
            PG8_LDA(At, 0, 1); PG8_STAGE(PG8_SA(0, 0), a2, voffA);
            PG8_BAR; PG8_WAIT_L(0); PG8_MMA(1, 0, At, B0); PG8_BAR; PG8_SCHED;
            PG8_STAGE(PG8_SB(0, 1), b2 + hstep, voffB);
            PG8_WAIT_V(6); PG8_BAR; PG8_MMA(1, 1, At, B1); PG8_BAR;
            PG8_LDB(B0, 1, 0); PG8_SCHED; PG8_LDA(At, 1, 0); PG8_STAGE(PG8_SA(0, 1), a2 + hstep, voffA);
            PG8_WAIT_L(8); PG8_BAR; PG8_WAIT_L(0); PG8_MMA(0, 0, At, B0); PG8_BAR; PG8_SCHED;
            PG8_LDB(B1, 1, 1); PG8_STAGE(PG8_SB(1, 0), b3, voffB);
            PG8_BAR; PG8_WAIT_L(0); PG8_MMA(0, 1, At, B1); PG8_BAR;
            PG8_LDA(At, 1, 1); PG8_STAGE(PG8_SA(1, 0), a3, voffA);
            PG8_BAR; PG8_WAIT_L(0); PG8_MMA(1, 0, At, B0); PG8_BAR; PG8_SCHED;
            PG8_STAGE(PG8_SB(1, 1), b3 + hstep, voffB);
            PG8_WAIT_V(6); PG8_BAR; PG8_MMA(1, 1, At, B1); PG8_BAR;
            }
        }
        if constexpr (ALIGN_EPI) { if (wr == 0) PG8_BAR; }
        if constexpr (!Epi::AFTER_DRAIN) { E(acc, cur, wr, wc, fr, fq); S.done(cur); }
        if (!has_next) break;
#pragma unroll
        for (int a = 0; a < 2; ++a)
#pragma unroll
            for (int b = 0; b < 2; ++b)
#pragma unroll
                for (int m = 0; m < 4; ++m)
#pragma unroll
                    for (int n = 0; n < 2; ++n) acc[a][b][m][n] = (f32x4){0.f, 0.f, 0.f, 0.f};
        cur = nxt; cA = nA; cB = nB; ++ui;
        if constexpr (ALIGN_EPI) { if (wr == 1) PG8_BAR; }
    }
    PG8_WAIT_V(0);
    if constexpr (!ALIGN_EPI) { if (wr == 0) PG8_BAR; }
    PG8_BAR;
    if constexpr (Epi::AFTER_DRAIN) { E.fused(acc, cur, wr, wc, fr, fq, lds, wid, lane); S.done(cur); }
#undef PG8_SA
#undef PG8_SB
#undef PG8_STAGE
#undef PG8_LDA
#undef PG8_LDB
#undef PG8_MMA
#undef PG8_WAIT_V
#undef PG8_WAIT_L
#undef PG8_BAR
#undef PG8_SCHED
}
}
constexpr int D = 1024, M = 16384, SEQ = 8192, DEPTH = 2;
constexpr int CC = 512, NQ = 8, NKV = 2, HD = 64, AW = 512, WIN = 128;
constexpr int INC = 2304, DFF = 2816, NGU = 2 * DFF;
constexpr int O_Q = 1536, O_K = 2048, O_V = 2176;
constexpr float EPS = 1e-6f, LOG2E = 1.4426950408889634f;
#define LAS __attribute__((address_space(3)))
#define GAS __attribute__((address_space(1)))
typedef unsigned short bf16;
typedef short bf16x8 __attribute__((ext_vector_type(8)));
typedef short s16x4 __attribute__((ext_vector_type(4)));
typedef float f32x4 __attribute__((ext_vector_type(4)));
typedef float f32x16 __attribute__((ext_vector_type(16)));
typedef unsigned u32x4 __attribute__((ext_vector_type(4)));
typedef float f32x2_t __attribute__((ext_vector_type(2))); typedef __bf16 bf16x2_t __attribute__((ext_vector_type(2)));
__device__ __forceinline__ unsigned cvtpk(float lo, float hi) { f32x2_t v = {lo, hi}; bf16x2_t b = __builtin_convertvector(v, bf16x2_t); return __builtin_bit_cast(unsigned, b); }
__device__ __forceinline__ float bf2f(short h) { return __builtin_bit_cast(float, (unsigned)(unsigned short)h << 16); }
__device__ __forceinline__ float bflo(unsigned w) { return __builtin_bit_cast(float, w << 16); }
__device__ __forceinline__ float bfhi(unsigned w) { return __builtin_bit_cast(float, w & 0xffff0000u); }

namespace mixer {
constexpr int LDS_K = 0, LDS_V = 49152, LDS_OST = 98304, LDS_WSF = 131072 + 1024, LDS_SRED = LDS_WSF + 2048;
__device__ __forceinline__ int crow(int r, int hi) { return (r & 3) + 8 * (r >> 2) + 4 * hi; }
__device__ __forceinline__ void qkt(f32x16& p0, f32x16& p1, const LAS unsigned char* Kslot, const bf16x8* qr, int r32, int hi) {
    const LAS unsigned char* kb = Kslot + hi * 1024 + r32 * 16;
    p0 = f32x16{}; p1 = f32x16{};
#pragma unroll
    for (int d0 = 0; d0 < 4; ++d0) {
        const bf16x8 b0 = *(const LAS bf16x8*)(kb + d0 * 2048), b1 = *(const LAS bf16x8*)(kb + d0 * 2048 + 512);
        p0 = __builtin_amdgcn_mfma_f32_32x32x16_bf16(b0, qr[d0], p0, 0, 0, 0);
        p1 = __builtin_amdgcn_mfma_f32_32x32x16_bf16(b1, qr[d0], p1, 0, 0, 0);
    }
}
__device__ __forceinline__ void pv(f32x16* o, int vb, bf16x8 pa0, bf16x8 pa1, bf16x8 pa2, bf16x8 pa3) {
#pragma unroll
    for (int d0 = 0; d0 < 2; ++d0) { s16x4 lo[4], hi[4];
#pragma unroll
        for (int ks = 0; ks < 4; ++ks) {
            asm volatile("ds_read_b64_tr_b16 %0,%1 offset:%c2" : "=&v"(lo[ks]) : "v"(vb), "i"(d0 * 4096 + ks * 1024) : "memory");
            asm volatile("ds_read_b64_tr_b16 %0,%1 offset:%c2" : "=&v"(hi[ks]) : "v"(vb), "i"(d0 * 4096 + ks * 1024 + 512) : "memory"); }
        asm volatile("s_waitcnt lgkmcnt(0)" ::: "memory"); __builtin_amdgcn_sched_barrier(0);
#define MX_PK(k) (bf16x8){lo[k][0], lo[k][1], lo[k][2], lo[k][3], hi[k][0], hi[k][1], hi[k][2], hi[k][3]}
        o[d0] = __builtin_amdgcn_mfma_f32_32x32x16_bf16(pa0, MX_PK(0), o[d0], 0, 0, 0);
        o[d0] = __builtin_amdgcn_mfma_f32_32x32x16_bf16(pa1, MX_PK(1), o[d0], 0, 0, 0);
        o[d0] = __builtin_amdgcn_mfma_f32_32x32x16_bf16(pa2, MX_PK(2), o[d0], 0, 0, 0);
        o[d0] = __builtin_amdgcn_mfma_f32_32x32x16_bf16(pa3, MX_PK(3), o[d0], 0, 0, 0);
#undef MX_PK
    }
}
__device__ __forceinline__ void load_u(const bf16* proj, long tokb, int tt, int c0, float (&u)[8]) {
    if (tt >= 0) { const bf16* pr = proj + (tokb + tt) * INC; const bf16x8 cg = *(const bf16x8*)(pr + CC + c0), hc = *(const bf16x8*)(pr + 2 * CC + c0);
#pragma unroll
        for (int j = 0; j < 8; ++j) u[j] = bf2f(cg[j]) * bf2f(hc[j]); }
    else {
#pragma unroll
        for (int j = 0; j < 8; ++j) u[j] = 0.f; }
}
__device__ __forceinline__ void unit(LAS unsigned char* lds, int un, const bf16* proj, const float* conv_w, const float* qg, const float* kg, const float* sinks, bf16* mix, const int tid) {
    const int lane = tid & 63, wid = __builtin_amdgcn_readfirstlane(tid >> 6), r32 = lane & 31, hi = lane >> 5;
    const int b = un >> 7, t0 = (un & 127) * 64; const long tokb = (long)b * SEQ, tok0 = tokb + t0;
    if (tid < 384) {
        const int kvh = tid / 192, r = tid % 192; int tk = t0 - 128 + r; if (tk < 0) tk = 0;
        const bf16* kr = proj + (tokb + tk) * INC + O_K + kvh * HD;
        bf16x8 c[8]; float ss = 0.f;
#pragma unroll
        for (int i = 0; i < 8; ++i) c[i] = *(const bf16x8*)(kr + 8 * i);
#pragma unroll
        for (int i = 0; i < 8; ++i)
#pragma unroll
            for (int j = 0; j < 8; ++j) { const float f = bf2f(c[i][j]); ss += f * f; }
        const float rs = __builtin_amdgcn_rsqf(ss * (1.0f / HD) + EPS);
        LAS unsigned char* dst = lds + LDS_K + (kvh * 3 + (r >> 6)) * 8192 + (r & 63) * 16;
#pragma unroll
        for (int i = 0; i < 8; ++i) { u32x4 w;
            w.x = cvtpk(bf2f(c[i][0]) * rs * kg[8 * i + 0], bf2f(c[i][1]) * rs * kg[8 * i + 1]); w.y = cvtpk(bf2f(c[i][2]) * rs * kg[8 * i + 2], bf2f(c[i][3]) * rs * kg[8 * i + 3]);
            w.z = cvtpk(bf2f(c[i][4]) * rs * kg[8 * i + 4], bf2f(c[i][5]) * rs * kg[8 * i + 5]); w.w = cvtpk(bf2f(c[i][6]) * rs * kg[8 * i + 6], bf2f(c[i][7]) * rs * kg[8 * i + 7]);
            *(LAS u32x4*)(dst + i * 1024) = w; }
    }
#pragma unroll
    for (int i = 0; i < 6; ++i) { const int it = tid + 512 * i, ch = it & 7, rr = it >> 3, kvh = rr / 192, r = rr % 192; int tk = t0 - 128 + r; if (tk < 0) tk = 0;
        const u32x4 v = *(const u32x4*)(proj + (tokb + tk) * INC + O_V + kvh * HD + ch * 8);
        *(LAS u32x4*)(lds + LDS_V + (kvh * 3 + (r >> 6)) * 8192 + (ch >> 2) * 4096 + (r & 63) * 64 + (ch & 3) * 16) = v; }
    {
        const int c0 = lane * 8; float w0[8], w1[8], w2[8], um2[8], um1[8];
#pragma unroll
        for (int j = 0; j < 8; ++j) { w0[j] = conv_w[c0 + j]; w1[j] = conv_w[CC + c0 + j]; w2[j] = conv_w[2 * CC + c0 + j]; }
        const int tf = t0 + 8 * wid;
        load_u(proj, tokb, tf - 2, c0, um2); load_u(proj, tokb, tf - 1, c0, um1);
#pragma unroll 2
        for (int i = 0; i < 8; ++i) { const bf16* pr = proj + (tokb + tf + i) * INC;
            const bf16x8 bg = *(const bf16x8*)(pr + c0), cg = *(const bf16x8*)(pr + CC + c0), hc = *(const bf16x8*)(pr + 2 * CC + c0);
            float y[8], ss = 0.f;
#pragma unroll
            for (int j = 0; j < 8; ++j) { const float u = bf2f(cg[j]) * bf2f(hc[j]); y[j] = bf2f(bg[j]) * (w0[j] * um2[j] + w1[j] * um1[j] + w2[j] * u); um2[j] = um1[j]; um1[j] = u; ss += y[j] * y[j]; }
#pragma unroll
            for (int o = 1; o < 64; o <<= 1) ss += __shfl_xor(ss, o);
            const float rs = __builtin_amdgcn_rsqf(ss * (1.0f / CC) + EPS);
            u32x4 w; w.x = cvtpk(y[0] * rs, y[1] * rs); w.y = cvtpk(y[2] * rs, y[3] * rs); w.z = cvtpk(y[4] * rs, y[5] * rs); w.w = cvtpk(y[6] * rs, y[7] * rs);
            *(u32x4*)(mix + (tok0 + 8 * wid + i) * D + c0) = w; }
    }
    __syncthreads();
    const int kvh = wid >> 2; const float sink2 = sinks[wid] * LOG2E;
    LAS float* wsf = (LAS float*)(lds + LDS_WSF) + wid * 64;
    LAS float* sred = (LAS float*)(lds + LDS_SRED);
    LAS bf16* stg = (LAS bf16*)(lds + LDS_OST) + wid * 2048;
    const LAS unsigned char* Kh = lds + LDS_K + kvh * 3 * 8192;
    const int vb0 = (int)(unsigned)(uintptr_t)(lds + LDS_V) + kvh * 3 * 8192 + ((lane >> 4) & 1) * 32 + (lane & 3) * 8 + (4 * hi + ((lane & 15) >> 2)) * 64;
#pragma unroll 1
    for (int qb = 0; qb < 2; ++qb) {
        const bf16* qp = proj + (tok0 + 32 * qb + r32) * INC + O_Q + wid * HD + hi * 8;
        bf16x8 qraw[4], qr[4]; float ss = 0.f;
#pragma unroll
        for (int d0 = 0; d0 < 4; ++d0) qraw[d0] = *(const bf16x8*)(qp + 16 * d0);
#pragma unroll
        for (int d0 = 0; d0 < 4; ++d0)
#pragma unroll
            for (int j = 0; j < 8; ++j) { const float f = bf2f(qraw[d0][j]); ss += f * f; }
        ss += __shfl_xor(ss, 32);
        const float qs = __builtin_amdgcn_rsqf(ss * (1.0f / HD) + EPS) * (0.125f * LOG2E);
#pragma unroll
        for (int d0 = 0; d0 < 4; ++d0) { const float* g = qg + 16 * d0 + 8 * hi; u32x4 w;
            w.x = cvtpk(bf2f(qraw[d0][0]) * qs * g[0], bf2f(qraw[d0][1]) * qs * g[1]); w.y = cvtpk(bf2f(qraw[d0][2]) * qs * g[2], bf2f(qraw[d0][3]) * qs * g[3]);
            w.z = cvtpk(bf2f(qraw[d0][4]) * qs * g[4], bf2f(qraw[d0][5]) * qs * g[5]); w.w = cvtpk(bf2f(qraw[d0][6]) * qs * g[6], bf2f(qraw[d0][7]) * qs * g[7]);
            qr[d0] = __builtin_bit_cast(bf16x8, w); }
        f32x16 p[3][2];
#pragma unroll
        for (int T = 0; T < 3; ++T) qkt(p[T][0], p[T][1], Kh + T * 8192, qr, r32, hi);
        const int qrel = 32 * qb + r32 + 128; float mx = sink2;
#pragma unroll
        for (int T = 0; T < 3; ++T)
#pragma unroll
            for (int h2 = 0; h2 < 2; ++h2)
#pragma unroll
                for (int r = 0; r < 16; ++r) { const int kr = 64 * T + 32 * h2 + crow(r, hi), diff = qrel - kr; const bool ok = (diff >= 0) && (diff < WIN) && (t0 - 128 + kr >= 0);
                    const float s = ok ? p[T][h2][r] : -1e30f; p[T][h2][r] = s; mx = fmaxf(mx, s); }
        mx = fmaxf(mx, __shfl_xor(mx, 32));
        float l = 0.f;
#pragma unroll
        for (int T = 0; T < 3; ++T)
#pragma unroll
            for (int h2 = 0; h2 < 2; ++h2)
#pragma unroll
                for (int r = 0; r < 16; ++r) { const float e = __builtin_amdgcn_exp2f(p[T][h2][r] - mx); p[T][h2][r] = e; l += e; }
        l += __shfl_xor(l, 32); l += __builtin_amdgcn_exp2f(sink2 - mx);
        f32x16 o[2]; o[0] = f32x16{}; o[1] = f32x16{};
#pragma unroll
        for (int T = 0; T < 3; ++T) { u32x4 a0, a1, a2, a3;
            a0 = (u32x4){cvtpk(p[T][0][0], p[T][0][1]), cvtpk(p[T][0][2], p[T][0][3]), cvtpk(p[T][0][4], p[T][0][5]), cvtpk(p[T][0][6], p[T][0][7])};
            a1 = (u32x4){cvtpk(p[T][0][8], p[T][0][9]), cvtpk(p[T][0][10], p[T][0][11]), cvtpk(p[T][0][12], p[T][0][13]), cvtpk(p[T][0][14], p[T][0][15])};
            a2 = (u32x4){cvtpk(p[T][1][0], p[T][1][1]), cvtpk(p[T][1][2], p[T][1][3]), cvtpk(p[T][1][4], p[T][1][5]), cvtpk(p[T][1][6], p[T][1][7])};
            a3 = (u32x4){cvtpk(p[T][1][8], p[T][1][9]), cvtpk(p[T][1][10], p[T][1][11]), cvtpk(p[T][1][12], p[T][1][13]), cvtpk(p[T][1][14], p[T][1][15])};
            pv(o, vb0 + T * 8192, __builtin_bit_cast(bf16x8, a0), __builtin_bit_cast(bf16x8, a1), __builtin_bit_cast(bf16x8, a2), __builtin_bit_cast(bf16x8, a3)); }
        if (hi == 0) wsf[r32] = __builtin_amdgcn_rcpf(l);
        asm volatile("s_waitcnt lgkmcnt(0)" ::: "memory");
#pragma unroll
        for (int r = 0; r < 16; ++r) { const float rl = wsf[crow(r, hi)]; o[0][r] *= rl; o[1][r] *= rl; }
#pragma unroll
        for (int r = 0; r < 16; ++r) { const int orow = crow(r, hi); stg[orow * 64 + r32] = (bf16)(cvtpk(o[0][r], 0.f) & 0xffffu); stg[orow * 64 + 32 + r32] = (bf16)(cvtpk(o[1][r], 0.f) & 0xffffu); }
        asm volatile("s_waitcnt lgkmcnt(0)" ::: "memory");
#pragma unroll
        for (int i = 0; i < 4; ++i) { const int row = i * 8 + (lane >> 3); const u32x4 v = *(const LAS u32x4*)(stg + row * 64 + (lane & 7) * 8);
            float s = bflo(v.x) * bflo(v.x) + bfhi(v.x) * bfhi(v.x) + bflo(v.y) * bflo(v.y) + bfhi(v.y) * bfhi(v.y) + bflo(v.z) * bflo(v.z) + bfhi(v.z) * bfhi(v.z) + bflo(v.w) * bflo(v.w) + bfhi(v.w) * bfhi(v.w);
            s += __shfl_xor(s, 1); s += __shfl_xor(s, 2); s += __shfl_xor(s, 4);
            if ((lane & 7) == 0) sred[(qb * 8 + wid) * 32 + row] = s; }
        __syncthreads();
        if (lane < 32) { float tot = 0.f;
#pragma unroll
            for (int h = 0; h < 8; ++h) tot += sred[(qb * 8 + h) * 32 + lane];
            wsf[32 + lane] = __builtin_amdgcn_rsqf(tot * (1.0f / AW) + EPS); }
        asm volatile("s_waitcnt lgkmcnt(0)" ::: "memory");
#pragma unroll
        for (int r = 0; r < 16; ++r) { const int orow = crow(r, hi); const float rn = wsf[32 + orow];
            stg[orow * 64 + r32] = (bf16)(cvtpk(o[0][r] * rn, 0.f) & 0xffffu); stg[orow * 64 + 32 + r32] = (bf16)(cvtpk(o[1][r] * rn, 0.f) & 0xffffu); }
        asm volatile("s_waitcnt lgkmcnt(0)" ::: "memory");
        bf16* Ow = mix + (tok0 + 32 * qb) * D + CC + wid * HD;
#pragma unroll
        for (int i = 0; i < 4; ++i) { const int row = i * 8 + (lane >> 3), ch = lane & 7; const u32x4 v = *(const LAS u32x4*)(stg + row * 64 + ch * 8); *(u32x4*)(Ow + (long)row * D + ch * 8) = v; }
    }
    __syncthreads();
}
}

constexpr size_t MiB = 1u << 20;
constexpr size_t WS_CTL = 0, CTL_BYTES = 320 * 1024;
constexpr size_t WS_RS = 64 * 1024;
constexpr size_t WS_W = 2 * MiB;
constexpr size_t W_IN = 0, W_O = (size_t)INC * D * 2, W_GU = W_O + (size_t)D * D * 2, W_D = W_GU + (size_t)NGU * D * 2, W_LAYER = W_D + (size_t)D * DFF * 2;
constexpr size_t WS_XB = 48 * MiB, WS_PROJ = 80 * MiB, WS_MIX = 152 * MiB, WS_ACT = 80 * MiB, WS_END = 184 * MiB;
static_assert(WS_W + 2 * W_LAYER <= WS_XB && WS_PROJ + (size_t)M * INC * 2 <= WS_MIX && WS_ACT + (size_t)M * DFF * 2 <= WS_END, "d_ws map");
constexpr int CW_BAR = 4096;
constexpr int RING_OFF = 0, RING_BYTES = 131072, LDSCTL_OFF = RING_BYTES, MISC_OFF = LDSCTL_OFF + 320, LDS_BYTES = 147456;
constexpr int NWAVES = 8;

typedef GAS unsigned gu32;
#define RLX_AGENT __ATOMIC_RELAXED, __HIP_MEMORY_SCOPE_AGENT
#define LDS_WAIT() asm volatile("s_waitcnt lgkmcnt(0)" ::: "memory")
__device__ __forceinline__ unsigned f2bf(float f) { unsigned u = __builtin_bit_cast(unsigned, f); return (u + 0x7fffu + ((u >> 16) & 1u)) >> 16; }
__device__ __forceinline__ unsigned pk2(float lo, float hi) { return f2bf(lo) | (f2bf(hi) << 16); }

#define XB_TMO      128
#define XB_XCNT(j)  (256  + 64 * (j))
#define XB_XSUB(j)  (1280 + 64 * (j))
#define XB_XGEN(j)  (2304 + 64 * (j))
#define XB_TOP      3328
#define XB_TOPGEN   3392
#define XCD_BAR_WORDS 3456
#define XB_SPIN_CAP (1u << 18)

__device__ __forceinline__ unsigned xb_ld(unsigned* p)              { return __hip_atomic_load(p, __ATOMIC_RELAXED, __HIP_MEMORY_SCOPE_AGENT); }
__device__ __forceinline__ unsigned xb_add(unsigned* p, unsigned v) { return __hip_atomic_fetch_add(p, v, __ATOMIC_RELAXED, __HIP_MEMORY_SCOPE_AGENT); }
__device__ __forceinline__ unsigned xb_xcc_id() { return (unsigned)__builtin_amdgcn_s_getreg((3 << 11) | 20) & 0xFu; }
#define XB_SPIN(cond, bar) do { unsigned _sp = 0; while (cond) { __builtin_amdgcn_s_sleep(1); \
    if ((++_sp & 255u) == 0u) { if (xb_ld(&(bar)[XB_TMO])) break; if (_sp > XB_SPIN_CAP) { atomicAdd(&(bar)[XB_TMO], 1u); break; } } } } while (0)

struct XcdBarrier {
    unsigned* bar; unsigned x;
    volatile LAS unsigned* st;
};

__device__ __forceinline__ XcdBarrier xcd_barrier_post(unsigned* bar, volatile LAS unsigned* st) {
    XcdBarrier b; b.bar = bar; b.x = xb_xcc_id(); b.st = st;
    if (threadIdx.x == 0) (void)xb_add(&bar[XB_XCNT(b.x)], 1u);
    return b;
}
__device__ __forceinline__ void xcd_barrier_complete(unsigned* bar, unsigned x, unsigned& nloc, unsigned& nx) {
    const unsigned G = gridDim.x * gridDim.y * gridDim.z;
    unsigned sum, cnt, mine, sp = 0u;
    for (;;) {
        sum = 0u; cnt = 0u; mine = 0u;
#pragma unroll
        for (unsigned j = 0; j < 16; ++j) { const unsigned c = xb_ld(&bar[XB_XCNT(j)]); sum += c; cnt += (c > 0u) ? 1u : 0u; mine = (j == x) ? c : mine; }
        if (sum == G) break;
        __builtin_amdgcn_s_sleep(1);
        if ((++sp & 255u) == 0u) { if (xb_ld(&bar[XB_TMO])) break; if (sp > XB_SPIN_CAP) { atomicAdd(&bar[XB_TMO], 1u); break; } }
    }
    nloc = mine > 0u ? mine : 1u; nx = cnt > 0u ? cnt : 1u;
}

__device__ __forceinline__ void xcd_barrier(const XcdBarrier& b) {
    asm volatile("s_waitcnt vmcnt(0)" ::: "memory");
    __syncthreads();
    if (threadIdx.x == 0) {
        unsigned* bar = b.bar;
        __builtin_amdgcn_s_waitcnt(0);
        unsigned nloc = b.st[0], nx = b.st[1];
        if (nloc == 0u) { xcd_barrier_complete(bar, b.x, nloc, nx); b.st[0] = nloc; b.st[1] = nx; }
        const unsigned old = xb_add(&bar[XB_XSUB(b.x)], 1u);
        const unsigned gen = old / nloc;
        if (old + 1u == (gen + 1u) * nloc) {
            __builtin_amdgcn_fence(__ATOMIC_RELEASE, "agent");
            asm volatile("s_waitcnt vmcnt(0)" ::: "memory");
            const unsigned og = xb_add(&bar[XB_TOP], 1u);
            const unsigned tg = og / nx;
            if (og + 1u == (tg + 1u) * nx) xb_add(&bar[XB_TOPGEN], 1u);
            else XB_SPIN(xb_ld(&bar[XB_TOPGEN]) == tg, bar);
            __builtin_amdgcn_fence(__ATOMIC_ACQUIRE, "agent");
            xb_add(&bar[XB_XGEN(b.x)], 1u);
            asm volatile("s_waitcnt vmcnt(0)" ::: "memory");
        } else {
            XB_SPIN(xb_ld(&bar[XB_XGEN(b.x)]) == gen, bar);
            __builtin_amdgcn_fence(__ATOMIC_ACQUIRE, "agent");
            asm volatile("s_waitcnt vmcnt(0)" ::: "memory");
        }
    }
    __syncthreads();
}

__device__ __forceinline__ void p0_tile(const float* W, int K, int N, bf16* WT, int mode, const float* g0, const float* g1, int gsplit, LAS unsigned* scr, int item, int lane) {
    const int nblk = N / 64, kb = item / nblk, nb = item % nblk, k0 = 64 * kb, n0 = 64 * nb, kq = lane >> 4, nq = lane & 15;
    f32x4 a[8], b[8];
#pragma unroll
    for (int i = 0; i < 8; ++i) { const float* p = W + (size_t)(k0 + 8 * i + 2 * kq) * N + n0 + 4 * nq; a[i] = *(const GAS f32x4*)p; b[i] = *(const GAS f32x4*)(p + N); }
#pragma unroll
    for (int i = 0; i < 8; ++i) { const int k = k0 + 8 * i + 2 * kq; float ga = 1.f, gb = 1.f;
        if (g0) { ga = (k < gsplit) ? g0[k] : g1[k - gsplit]; gb = (k + 1 < gsplit) ? g0[k + 1] : g1[k + 1 - gsplit]; }
#pragma unroll
        for (int e = 0; e < 4; ++e) scr[(4 * nq + e) * 33 + 4 * i + kq] = cvtpk(a[i][e] * ga, b[i][e] * gb); }
    LDS_WAIT(); asm volatile("" ::: "memory");
    int r0 = n0; if (mode) r0 = (n0 / 128) * 256 + (n0 % 128) + (mode == 2 ? 128 : 0);
    const int c = lane & 7;
#pragma unroll
    for (int j = 0; j < 8; ++j) { const int n = (lane >> 3) + 8 * j; const LAS unsigned* s = scr + n * 33 + 4 * c;
        u32x4 o; o.x = s[0]; o.y = s[1]; o.z = s[2]; o.w = s[3];
        *(GAS u32x4*)(WT + (size_t)(r0 + n) * K + k0 + 8 * c) = o; }
    LDS_WAIT(); asm volatile("" ::: "memory");
}
constexpr int I_IN = (D / 64) * (INC / 64), I_O = (D / 64) * (D / 64), I_G = (D / 64) * (DFF / 64), I_D = (DFF / 64) * (D / 64), I_L = I_IN + I_O + 2 * I_G + I_D;
struct Args { const float* in[14]; float* out; unsigned char* ws; };
__device__ __forceinline__ void cvt_item(const Args& args, int it, LAS unsigned* scr, int lane) {
    const int l = it / I_L; int r = it % I_L; unsigned char* wl = args.ws + WS_W + l * W_LAYER;
    if (r < I_IN) { p0_tile(args.in[2] + (size_t)l * D * INC, D, INC, (bf16*)(wl + W_IN), 0, args.in[1] + l * D, args.in[1] + l * D, D, scr, r, lane); return; } r -= I_IN;
    if (r < I_O) { p0_tile(args.in[9] + (size_t)l * D * D, D, D, (bf16*)(wl + W_O), 0, args.in[7] + l * CC, args.in[8] + l * AW, CC, scr, r, lane); return; } r -= I_O;
    if (r < I_G) { p0_tile(args.in[11] + (size_t)l * D * DFF, D, DFF, (bf16*)(wl + W_GU), 1, args.in[10] + l * D, args.in[10] + l * D, D, scr, r, lane); return; } r -= I_G;
    if (r < I_G) { p0_tile(args.in[12] + (size_t)l * D * DFF, D, DFF, (bf16*)(wl + W_GU), 2, args.in[10] + l * D, args.in[10] + l * D, D, scr, r, lane); return; } r -= I_G;
    p0_tile(args.in[13] + (size_t)l * DFF * D, DFF, D, (bf16*)(wl + W_D), 0, nullptr, nullptr, 0, scr, r, lane);
}
__device__ __forceinline__ void cvt_fill(const Args& args, int lo, int hi, int nwg, int G, int bx, int wave, int lane, LAS unsigned char* lds) {
    const int extra = nwg % G; if (bx < extra) return;
    LAS unsigned* scr = (LAS unsigned*)(lds + RING_OFF + wave * 16384);
    for (int it = lo + (bx - extra) * NWAVES + wave; it < hi; it += (G - extra) * NWAVES) cvt_item(args, it, scr, lane);
}
__device__ __forceinline__ void x_row(const float* xrow, bf16* orow, float* rs, int lane) {
    const GAS f32x4* xr = (const GAS f32x4*)xrow + lane; float s = 0.f; f32x4 v[4];
#pragma unroll
    for (int j = 0; j < 4; ++j) { v[j] = xr[64 * j]; s += (v[j].x * v[j].x + v[j].y * v[j].y) + (v[j].z * v[j].z + v[j].w * v[j].w); }
#pragma unroll
    for (int o = 1; o < 64; o <<= 1) s += __shfl_xor(s, o);
    GAS unsigned long long* o8 = (GAS unsigned long long*)orow + lane;
#pragma unroll
    for (int j = 0; j < 4; ++j) o8[64 * j] = (unsigned long long)pk2(v[j].x, v[j].y) | ((unsigned long long)pk2(v[j].z, v[j].w) << 32);
    if (lane == 0) *rs = s;
}

__device__ __forceinline__ int opq_tid() { int t = threadIdx.x; asm volatile("" : "+v"(t)); return t; }
#define OPQ_TID() opq_tid()
__global__ void __launch_bounds__(NWAVES * 64, 2) hymba_fwd(Args args) {
    extern __shared__ __attribute__((aligned(16))) unsigned char lds_raw[];
    LAS unsigned char* lds = (LAS unsigned char*)lds_raw;
    volatile LAS unsigned* MISC = (volatile LAS unsigned*)(lds + MISC_OFF);
    const int tid = threadIdx.x, lane = tid & 63, wave = __builtin_amdgcn_readfirstlane(tid >> 6);
    const int G = gridDim.x, bx = blockIdx.x, vcu = (G % 8 == 0) ? (bx % 8) * (G / 8) + bx / 8 : bx;
    unsigned char* ws = args.ws;
    gu32* ctl = (gu32*)(ws + WS_CTL);
    const float* x = args.in[0]; float* out = args.out;
    float* RS = (float*)(ws + WS_RS);
    bf16* XB = (bf16*)(ws + WS_XB); bf16* PROJ = (bf16*)(ws + WS_PROJ); bf16* MIX = (bf16*)(ws + WS_MIX); bf16* ACT = (bf16*)(ws + WS_ACT);
    for (int u = tid; u < (LDS_BYTES - LDSCTL_OFF) / 4; u += NWAVES * 64) ((LAS unsigned*)(lds + LDSCTL_OFF))[u] = 0u;
    __syncthreads();
    XcdBarrier bar = xcd_barrier_post((unsigned*)(ctl + CW_BAR), MISC + 8);

    {
        LAS unsigned* scr = (LAS unsigned*)(lds + RING_OFF + wave * 16384);
        const int gw = vcu * NWAVES + wave, NGW = G * NWAVES;
        for (int it = gw; it < I_IN; it += NGW) cvt_item(args, it, scr, lane);
        for (int m = gw; m < M; m += NGW) x_row(x + (size_t)m * D, XB + (size_t)m * D, RS + m, lane);
    }
    xcd_barrier(bar);

#pragma unroll 1
    for (int l = 0; l < DEPTH; ++l) {
        unsigned char* wl = ws + WS_W + l * W_LAYER;
        float* rs1 = RS + (size_t)M * (2 * l), *rs2 = RS + (size_t)M * (2 * l + 1), *rs_next = RS + (size_t)M * (2 * l + 2);
        { pg8::Gemm g{XB, (const bf16*)(wl + W_IN), M, INC, D}; pg8::StaticOrder S; S.init(M, INC, G, bx);
          pg8::EpiProj E{PROJ, INC, rs1};
          pg8::gemm_phase<pg8::EpiProj, pg8::StaticOrder, true, true>(lds + RING_OFF, g, S, E, OPQ_TID());
          if (l == 0) cvt_fill(args, I_IN, I_L, (M / 256) * (INC / 256), G, bx, wave, OPQ_TID() & 63, lds); }
        xcd_barrier(bar);
        for (int un = vcu; un < M / 64; un += G)
            mixer::unit(lds, un, PROJ, args.in[3] + l * 3 * CC, args.in[4] + l * HD, args.in[5] + l * HD, args.in[6] + l * NQ, MIX, OPQ_TID());
        xcd_barrier(bar);
        { pg8::Gemm g{MIX, (const bf16*)(wl + W_O), M, D, D}; pg8::StaticOrder S; S.init(M, D, G, bx);
          pg8::EpiRes E{l == 0 ? x : nullptr, XB, nullptr, XB, rs2};
          pg8::gemm_phase<pg8::EpiRes, pg8::StaticOrder, true, true>(lds + RING_OFF, g, S, E, OPQ_TID()); }
        xcd_barrier(bar);
        { pg8::Gemm g{XB, (const bf16*)(wl + W_GU), M, NGU, D}; pg8::StaticOrder S; S.init(M, NGU, G, bx);
          pg8::EpiGU E{ACT, DFF, rs2};
          pg8::gemm_phase<pg8::EpiGU, pg8::StaticOrder, true, true>(lds + RING_OFF, g, S, E, OPQ_TID());
          if (l == 0) cvt_fill(args, I_L, 2 * I_L, (M / 256) * (NGU / 256), G, bx, wave, OPQ_TID() & 63, lds); }
        xcd_barrier(bar);
        { pg8::Gemm g{ACT, (const bf16*)(wl + W_D), M, D, DFF}; pg8::StaticOrder S; S.init(M, D, G, bx);
          pg8::EpiRes E{nullptr, XB, l + 1 < DEPTH ? nullptr : out, l + 1 < DEPTH ? XB : nullptr, l + 1 < DEPTH ? rs_next : nullptr};
          pg8::gemm_phase<pg8::EpiRes, pg8::StaticOrder, true, true>(lds + RING_OFF, g, S, E, OPQ_TID()); }
        if (l + 1 < DEPTH) xcd_barrier(bar);
    }
}

extern "C" void kernel_launch(void* const* d_in, const int* in_sizes, int n_in, void* d_out, int out_size, void* d_ws, size_t ws_size, hipStream_t stream) {
    static int grid = 0;
    if (grid == 0) {
        if (n_in != 14 || in_sizes[0] != M * D || out_size != M * D || ws_size < WS_END) { fprintf(stderr, "kernel_launch: unexpected shapes (n_in %d, out %d, ws %zu); nothing launched\n", n_in, out_size, ws_size); grid = -1; return; }
        int dev = 0, cus = 0, per_cu = 0;
        if (hipGetDevice(&dev) != hipSuccess || hipDeviceGetAttribute(&cus, hipDeviceAttributeMultiprocessorCount, dev) != hipSuccess) { grid = -1; return; }
        if (hipFuncSetAttribute((const void*)hymba_fwd, hipFuncAttributeMaxDynamicSharedMemorySize, LDS_BYTES) != hipSuccess) { fprintf(stderr, "kernel_launch: hipFuncSetAttribute failed\n"); grid = -1; return; }
        if (hipOccupancyMaxActiveBlocksPerMultiprocessor(&per_cu, (const void*)hymba_fwd, NWAVES * 64, LDS_BYTES) != hipSuccess || per_cu < 1) { fprintf(stderr, "kernel_launch: occupancy query says %d\n", per_cu); per_cu = 1; }
        (void)hipGetLastError();
        grid = cus * (per_cu < 1 ? 1 : 1);
    }
    if (grid < 0) return;
    if (hipMemsetAsync((char*)d_ws + WS_CTL, 0, CTL_BYTES, stream) != hipSuccess) { fprintf(stderr, "kernel_launch: memset failed\n"); return; }
    Args a{};
    for (int i = 0; i < 14; ++i) a.in[i] = (const float*)d_in[i];
    a.out = (float*)d_out; a.ws = (unsigned char*)d_ws;
    hipLaunchKernelGGL(hymba_fwd, dim3(grid), dim3(NWAVES * 64), LDS_BYTES, stream, a);
    const hipError_t le = hipPeekAtLastError();
    if (le != hipSuccess) fprintf(stderr, "kernel_launch: launch failed: %s\n", hipGetErrorName(le));
}
```
